# Optimizing an MI355X kernel written in HIP

```python
import math
import jax, jax.numpy as jnp
from jax import lax
import numpy as np

D_MODEL = 1024
BATCH = 16
SEQ = 2048
DEPTH = 2

CTX_LEN = 256
GRID_W = 64
EPS = 1e-6

DIFF_HEADS = 4
DIFF_DK = 64
DIFF_DV = 2 * DIFF_DK
DIFF_WIDTH = DIFF_HEADS * DIFF_DV
DIFF_QK_WIDTH = DIFF_HEADS * 2 * DIFF_DK
ROPE_THETA = 10000.0
Q_BLOCK = 128
FNET_GROUPS = 4
FNET_GROUP_CH = 64
FNET_WIDTH = FNET_GROUPS * FNET_GROUP_CH
S5_CH = 16
S5_GROUPS = 16
S5_STATE = 64
S5_WIDTH = S5_GROUPS * S5_CH
DT_MIN = 1e-3
DT_MAX = 1e-1
D_MIX = DIFF_WIDTH + FNET_WIDTH + S5_WIDTH
IN_WIDTH = 2 * DIFF_QK_WIDTH + DIFF_WIDTH + FNET_WIDTH + S5_WIDTH
F_DENSE = 2816
N_EXPERTS = 8
TOP_K = 2
F_EXPERT = 3584
N_DENSE_LAYERS = (DEPTH + 1) // 2
N_MOE_LAYERS = DEPTH // 2

kernel_name = 'hybrid_diffattn_fnet_s5_moe_prefix_dit'


def rms_norm(x, g):
    xf = x.astype(jnp.float32)
    y = xf * lax.rsqrt(jnp.mean(xf * xf, axis=-1, keepdims=True) + EPS)
    return (y * g.astype(jnp.float32)).astype(x.dtype)


def rope_2d(x, rows, cols):
    half = DIFF_DK // 2
    n_freq = half // 2
    inv = ROPE_THETA ** (-jnp.arange(n_freq, dtype=jnp.float32) / n_freq)
    extra = x.ndim - 3

    def rot(xa, pos):
        ang = pos.astype(jnp.float32)[:, None] * inv
        ang = ang.reshape((ang.shape[0],) + (1,) * extra + (n_freq,))
        cos = jnp.cos(ang).astype(x.dtype)
        sin = jnp.sin(ang).astype(x.dtype)
        x1, x2 = xa[..., :n_freq], xa[..., n_freq:]
        return jnp.concatenate([x1 * cos - x2 * sin, x2 * cos + x1 * sin], axis=-1)

    return jnp.concatenate([rot(x[..., :half], rows), rot(x[..., half:], cols)], axis=-1)


def split_in(p):
    b, l_, _ = p.shape
    q = p[..., :DIFF_QK_WIDTH].reshape(b, l_, DIFF_HEADS, 2, DIFF_DK)
    k = p[..., DIFF_QK_WIDTH:2 * DIFF_QK_WIDTH].reshape(b, l_, DIFF_HEADS, 2, DIFF_DK)
    o = 2 * DIFF_QK_WIDTH
    v = p[..., o:o + DIFF_WIDTH].reshape(b, l_, DIFF_HEADS, DIFF_DV)
    o = o + DIFF_WIDTH
    f = p[..., o:o + FNET_WIDTH]
    u = p[..., o + FNET_WIDTH:]
    return q, k, v, f, u


def diff_attend(q1, q2, k1, k2, v, lam):
    scale = DIFF_DK ** -0.5
    p1 = jax.nn.softmax(jnp.einsum('bhqd,bhkd->bhqk', q1, k1).astype(jnp.float32) * scale, axis=-1)
    p2 = jax.nn.softmax(jnp.einsum('bhqd,bhkd->bhqk', q2, k2).astype(jnp.float32) * scale, axis=-1)
    return jnp.einsum('bhqk,bhkd->bhqd', (p1 - lam * p2).astype(v.dtype), v)


def diff_attention(q, k, v, qc, kc, vc, lam, lam_init, subln, rows, cols, need_ctx):
    q = rope_2d(q, rows, cols)
    k = rope_2d(k, rows, cols)
    heads = lambda t: jnp.moveaxis(t, 2, 1)
    q, k, v, qc, kc, vc = (heads(t) for t in (q, k, v, qc, kc, vc))
    k_all = jnp.concatenate([kc, k], axis=2)
    v_all = jnp.concatenate([vc, v], axis=2)
    k1, k2 = k_all[..., 0, :], k_all[..., 1, :]
    b, h, s = q.shape[:3]
    nblk = s // Q_BLOCK
    qb = jnp.moveaxis(q.reshape(b, h, nblk, Q_BLOCK, 2, DIFF_DK), 2, 0)
    o = lax.map(lambda qq: diff_attend(qq[..., 0, :], qq[..., 1, :], k1, k2, v_all, lam), qb)
    o = jnp.moveaxis(o, 0, 2).reshape(b, h, s, DIFF_DV)

    def finish(t):
        t = rms_norm(t, subln) * (1.0 - lam_init)
        return jnp.moveaxis(t, 1, 2).reshape(t.shape[0], t.shape[2], DIFF_WIDTH)

    out_c = None
    if need_ctx:
        out_c = finish(diff_attend(qc[..., 0, :], qc[..., 1, :], kc[..., 0, :], kc[..., 1, :], vc, lam))
    return finish(o), out_c


def fourier_mix(f, w):
    b, l_, _ = f.shape
    g = f.astype(jnp.float32).reshape(b, l_, FNET_GROUPS, FNET_GROUP_CH)
    mixed = jnp.fft.fft2(g, axes=(1, 3), norm='ortho').real.reshape(b, l_, FNET_WIDTH).astype(f.dtype)
    return mixed @ w


def s5_discretize(a_re, a_im, log_dt, b_re, b_im):
    f32 = jnp.float32
    a_re, a_im = a_re.astype(f32), a_im.astype(f32)
    b_re, b_im = b_re.astype(f32), b_im.astype(f32)
    dt = jnp.exp(log_dt.astype(f32))[:, None]
    mag = jnp.exp(a_re * dt)
    lr, li = mag * jnp.cos(a_im * dt), mag * jnp.sin(a_im * dt)
    nr, ni = lr - 1.0, li
    den = a_re * a_re + a_im * a_im
    cr = (nr * a_re + ni * a_im) / den
    ci = (ni * a_re - nr * a_im) / den
    bbr = cr[..., None] * b_re - ci[..., None] * b_im
    bbi = cr[..., None] * b_im + ci[..., None] * b_re
    return lr, li, bbr, bbi


def complex_scan(lr, li, br, bi, h0r, h0i, reverse):
    l_ = br.shape[1]
    if h0r is not None:
        first = -1 if reverse else 0
        br = br.at[:, first].add(lr * h0r - li * h0i)
        bi = bi.at[:, first].add(lr * h0i + li * h0r)
    ar = jnp.broadcast_to(lr, (1, l_) + lr.shape)
    ai = jnp.broadcast_to(li, (1, l_) + li.shape)

    def combine(e1, e2):
        a1r, a1i, b1r, b1i = e1
        a2r, a2i, b2r, b2i = e2
        return (a2r * a1r - a2i * a1i, a2r * a1i + a2i * a1r,
                a2r * b1r - a2i * b1i + b2r, a2r * b1i + a2i * b1r + b2i)

    _, _, hr, hi = lax.associative_scan(combine, (ar, ai, br, bi), reverse=reverse, axis=1)
    return hr, hi


def s5_readout(hr, hi, c_re, c_im):
    f32 = jnp.float32
    return jnp.einsum('blgp,gcp->blgc', hr, c_re.astype(f32)) - jnp.einsum('blgp,gcp->blgc', hi, c_im.astype(f32))


def s5_mixer(u, uc, a_re, a_im, log_dt, b_re, b_im, c_re, c_im, d, w_glu, need_ctx):
    f32 = jnp.float32

    def drive(t, bbr, bbi):
        tg = t.astype(f32).reshape(t.shape[0], t.shape[1], S5_GROUPS, S5_CH)
        return jnp.einsum('blgc,gpc->blgp', tg, bbr), jnp.einsum('blgc,gpc->blgp', tg, bbi)

    y, yc = 0.0, 0.0
    for direction, reverse in ((0, False), (1, True)):
        lr, li, bbr, bbi = s5_discretize(a_re[direction], a_im[direction], log_dt[direction],
                                         b_re[direction], b_im[direction])
        hcr, hci = complex_scan(lr, li, *drive(uc, bbr, bbi), None, None, reverse)
        end = 0 if reverse else -1
        hr, hi = complex_scan(lr, li, *drive(u, bbr, bbi), hcr[:, end], hci[:, end], reverse)
        y = y + s5_readout(hr, hi, c_re[direction], c_im[direction])
        if need_ctx:
            yc = yc + s5_readout(hcr, hci, c_re[direction], c_im[direction])

    def finish(yy, t):
        yy = yy.reshape(t.shape[0], t.shape[1], S5_WIDTH) + d.astype(f32) * t.astype(f32)
        yy = jax.nn.gelu(yy)
        return (yy * jax.nn.sigmoid(yy @ w_glu.astype(f32))).astype(t.dtype)

    return finish(y, u), (finish(yc, uc) if need_ctx else None)


def swiglu(t, wg, wu, wd):
    return (jax.nn.silu(t @ wg) * (t @ wu)) @ wd


def moe_swiglu(t, router, wg, wu, wd):
    b, l_, d_ = t.shape
    tok = t.reshape(-1, d_)
    probs = jax.nn.softmax((tok @ router).astype(jnp.float32), axis=-1)
    top_p, top_i = lax.top_k(probs, TOP_K)
    top_p = top_p / jnp.sum(top_p, axis=-1, keepdims=True)
    gates = jnp.sum(jax.nn.one_hot(top_i, N_EXPERTS, dtype=jnp.float32) * top_p[..., None], axis=1)
    out = jnp.zeros_like(tok)
    for e in range(N_EXPERTS):
        out = out + gates[:, e:e + 1].astype(t.dtype) * swiglu(tok, wg[e], wu[e], wd[e])
    return out.reshape(b, l_, d_)


def setup_inputs(seed: int = 0) -> dict:
    key = jax.random.key(seed)
    ks = iter(jax.random.split(key, 48))
    f32 = jnp.float32
    nrm = lambda shape, scale: jax.random.normal(next(ks), shape, f32) * scale
    G, P, C, D = S5_GROUPS, S5_STATE, S5_CH, D_MODEL
    a_im_init = jnp.pi * jnp.arange(P, dtype=f32)
    return {
        'x': nrm((BATCH, SEQ, D), 1.0),
        'c': nrm((BATCH, D), 1.0),
        'ctx': nrm((BATCH, CTX_LEN, D), 1.0),
        'c_ctx': nrm((D,), 1.0),
        'ada_w': nrm((DEPTH, D, 6 * D), 0.5 * D ** -0.5),
        'ada_b': nrm((DEPTH, 6 * D), 0.02),
        'norm_mix_pre': 1.0 + nrm((DEPTH, D), 0.05),
        'norm_mix_post': 1.0 + nrm((DEPTH, D), 0.05),
        'norm_ffn_pre': 1.0 + nrm((DEPTH, D), 0.05),
        'norm_ffn_post': 1.0 + nrm((DEPTH, D), 0.05),
        'w_in': nrm((DEPTH, D, IN_WIDTH), D ** -0.5),
        'w_out': nrm((DEPTH, D_MIX, D), D_MIX ** -0.5),
        'diff_lq1': nrm((DEPTH, DIFF_DK), 0.1),
        'diff_lk1': nrm((DEPTH, DIFF_DK), 0.1),
        'diff_lq2': nrm((DEPTH, DIFF_DK), 0.1),
        'diff_lk2': nrm((DEPTH, DIFF_DK), 0.1),
        'diff_subln': 1.0 + nrm((DEPTH, DIFF_DV), 0.05),
        'fnet_w': nrm((DEPTH, FNET_WIDTH, FNET_WIDTH), FNET_WIDTH ** -0.5),
        's5_a_re': -0.5 + nrm((DEPTH, 2, G, P), 0.01),
        's5_a_im': a_im_init + nrm((DEPTH, 2, G, P), 0.01),
        's5_log_dt': jax.random.uniform(next(ks), (DEPTH, 2, G), f32, math.log(DT_MIN), math.log(DT_MAX)),
        's5_b_re': nrm((DEPTH, 2, G, P, C), (2 * C) ** -0.5),
        's5_b_im': nrm((DEPTH, 2, G, P, C), (2 * C) ** -0.5),
        's5_c_re': nrm((DEPTH, 2, G, C, P), (2 * P) ** -0.5),
        's5_c_im': nrm((DEPTH, 2, G, C, P), (2 * P) ** -0.5),
        's5_d': nrm((DEPTH, S5_WIDTH), 1.0),
        's5_w_glu': nrm((DEPTH, S5_WIDTH, S5_WIDTH), S5_WIDTH ** -0.5),
        'ffn_w_gate': nrm((N_DENSE_LAYERS, D, F_DENSE), D ** -0.5),
        'ffn_w_up': nrm((N_DENSE_LAYERS, D, F_DENSE), D ** -0.5),
        'ffn_w_down': nrm((N_DENSE_LAYERS, F_DENSE, D), F_DENSE ** -0.5),
        'moe_router': nrm((N_MOE_LAYERS, D, N_EXPERTS), D ** -0.5),
        'moe_w_gate': nrm((N_MOE_LAYERS, N_EXPERTS, D, F_EXPERT), D ** -0.5),
        'moe_w_up': nrm((N_MOE_LAYERS, N_EXPERTS, D, F_EXPERT), D ** -0.5),
        'moe_w_down': nrm((N_MOE_LAYERS, N_EXPERTS, F_EXPERT, D), F_EXPERT ** -0.5),
    }


def reference(x, c, ctx, c_ctx, ada_w, ada_b, norm_mix_pre, norm_mix_post, norm_ffn_pre, norm_ffn_post,
              w_in, w_out, diff_lq1, diff_lk1, diff_lq2, diff_lk2, diff_subln, fnet_w,
              s5_a_re, s5_a_im, s5_log_dt, s5_b_re, s5_b_im, s5_c_re, s5_c_im, s5_d, s5_w_glu,
              ffn_w_gate, ffn_w_up, ffn_w_down, moe_router, moe_w_gate, moe_w_up, moe_w_down):
    f32 = jnp.float32
    s = x.shape[1]
    ROWS = s // GRID_W
    rows = jnp.repeat(jnp.arange(ROWS, dtype=jnp.int32), GRID_W)
    cols = jnp.tile(jnp.arange(GRID_W, dtype=jnp.int32), ROWS)
    silu_c = jax.nn.silu(c)
    silu_cc = jax.nn.silu(c_ctx)
    xc = ctx
    for l in range(DEPTH):
        need_ctx = l < DEPTH - 1
        mod = silu_c @ ada_w[l] + ada_b[l]
        mod_c = silu_cc @ ada_w[l] + ada_b[l]
        sh_m, sc_m, g_m, sh_f, sc_f, g_f = jnp.split(mod[:, None, :], 6, axis=-1)
        csh_m, csc_m, cg_m, csh_f, csc_f, cg_f = jnp.split(mod_c, 6, axis=-1)

        h = rms_norm(x, norm_mix_pre[l]) * (1.0 + sc_m) + sh_m
        hc = rms_norm(xc, norm_mix_pre[l]) * (1.0 + csc_m) + csh_m
        q, k, v, f, u = split_in(h @ w_in[l])
        qc, kc, vc, fc, uc = split_in(hc @ w_in[l])

        lam_init = 0.8 - 0.6 * math.exp(-0.3 * l)
        lam = (jnp.exp(jnp.sum(diff_lq1[l].astype(f32) * diff_lk1[l].astype(f32)))
               - jnp.exp(jnp.sum(diff_lq2[l].astype(f32) * diff_lk2[l].astype(f32))) + lam_init)
        a_lat, a_ctx = diff_attention(q, k, v, qc, kc, vc, lam, lam_init, diff_subln[l], rows, cols, need_ctx)
        f_lat = fourier_mix(f, fnet_w[l])
        s_lat, s_ctx = s5_mixer(u, uc, s5_a_re[l], s5_a_im[l], s5_log_dt[l], s5_b_re[l], s5_b_im[l],
                                s5_c_re[l], s5_c_im[l], s5_d[l], s5_w_glu[l], need_ctx)
        mix = jnp.concatenate([a_lat, f_lat, s_lat], axis=-1) @ w_out[l]
        x = x + g_m * rms_norm(mix, norm_mix_post[l])
        if need_ctx:
            mix_c = jnp.concatenate([a_ctx, fourier_mix(fc, fnet_w[l]), s_ctx], axis=-1) @ w_out[l]
            xc = xc + cg_m * rms_norm(mix_c, norm_mix_post[l])

        i = l // 2
        if l % 2 == 0:
            ffn = lambda t: swiglu(t, ffn_w_gate[i], ffn_w_up[i], ffn_w_down[i])
        else:
            ffn = lambda t: moe_swiglu(t, moe_router[i], moe_w_gate[i], moe_w_up[i], moe_w_down[i])
        h = rms_norm(x, norm_ffn_pre[l]) * (1.0 + sc_f) + sh_f
        x = x + g_f * rms_norm(ffn(h), norm_ffn_post[l])
        if need_ctx:
            hc = rms_norm(xc, norm_ffn_pre[l]) * (1.0 + csc_f) + csh_f
            xc = xc + cg_f * rms_norm(ffn(hc), norm_ffn_post[l])
    return x
```

```cpp
#include <hip/hip_runtime.h>
#include <cstdio>
#include <cstdint>

#ifndef MK_ONE_LAUNCH
#define MK_ONE_LAUNCH 1
#endif

#define GAS __attribute__((address_space(1)))
#define LAS __attribute__((address_space(3)))
typedef unsigned short bf16;
typedef short bf16x8 __attribute__((ext_vector_type(8)));
typedef short s16x4 __attribute__((ext_vector_type(4)));
typedef float f32x2 __attribute__((ext_vector_type(2)));
typedef float f32x4 __attribute__((ext_vector_type(4)));
typedef float f32x8 __attribute__((ext_vector_type(8)));
typedef float f32x16 __attribute__((ext_vector_type(16)));
typedef unsigned u32x2 __attribute__((ext_vector_type(2)));
typedef unsigned u32x4 __attribute__((ext_vector_type(4)));

constexpr int NB = 16, SQ = 2048, CT = 256, SA = 2304, MR = NB * SA, DM = 1024;
constexpr int NWIN = 2304;
constexpr int FD = 2816, FE = 3584, NEXP = 8;
constexpr int CHT = 16;
constexpr int NCH = 144;
constexpr int S5ROWS = 2304;
constexpr int S5K1 = 256, S5K2 = 512;
constexpr int NP_CAP = 264;
constexpr float EPS = 1e-6f;

constexpr size_t MiB = 1u << 20;
constexpr size_t WS_CTL = 0, CTL_ZERO_BYTES = 1 * MiB;
constexpr size_t WS_MODS = 1 * MiB;
constexpr size_t WS_WCWS = 2 * MiB;
constexpr size_t WS_ROPE = 3 * MiB;
constexpr size_t WS_TOK = 4 * MiB;
constexpr size_t WS_S5POW = 6 * MiB;
constexpr size_t WS_S5POWT = 9 * MiB;
constexpr size_t WS_WIN = 16 * MiB;
constexpr size_t WS_WOUT = 25 * MiB;
constexpr size_t WS_WGU = 29 * MiB;
constexpr size_t WS_WD = 40 * MiB;
constexpr size_t WS_GLU = 46 * MiB;
constexpr size_t WS_DFTC = 46 * MiB + 512 * 1024;
constexpr size_t WS_DFTL = 47 * MiB;
constexpr size_t WS_KIN = 80 * MiB;
constexpr size_t WS_KTOT = 82 * MiB;
constexpr size_t WS_HN = 130 * MiB;
constexpr size_t WS_Q = 202 * MiB, WS_K = 238 * MiB, WS_V = 274 * MiB;
constexpr size_t WS_FT2 = 310 * MiB;
constexpr size_t WS_FTC = 342 * MiB;
constexpr size_t WS_UA = 346 * MiB;
constexpr size_t WS_HLOC = 88 * MiB;
constexpr size_t WS_AO = 390 * MiB;
constexpr size_t WS_CAT = 462 * MiB;
constexpr size_t WS_YY = 534 * MiB;
constexpr size_t WS_X1C = 552 * MiB;
constexpr size_t WS_H2_L0 = 202 * MiB;
constexpr size_t WS_HID = 274 * MiB;
constexpr size_t WS_MW = 16 * MiB;
constexpr size_t MW_EXP = 10 * MiB + 512 * 1024, MW_D_OFF = 7 * MiB;
constexpr size_t WS_ASORT = 100 * MiB;
constexpr size_t WS_Y = 166 * MiB;
constexpr size_t WS_HIDC = 298 * MiB;
constexpr size_t WS_H2_L1 = 316 * MiB;
constexpr size_t WS_CPART = 534 * MiB;
constexpr size_t WS_Y2 = 529 * MiB;
constexpr size_t WS_END = 568 * MiB;
constexpr float MOE_WS = 64.f, MOE_AS = 16.f, MOE_HS = 4.f;

constexpr int CW_TMO = 0, CW_CODE = 1, CW_MOECNT = 1024  , CW_BAR = 4096;

#define LDS_WAIT() asm volatile("s_waitcnt lgkmcnt(0)" ::: "memory")
#define VM_WAIT() asm volatile("s_waitcnt vmcnt(0)" ::: "memory")
#define RLX_AGENT __ATOMIC_RELAXED, __HIP_MEMORY_SCOPE_AGENT
__device__ __forceinline__ unsigned cvt_pk_bf16(float lo, float hi) { unsigned r; asm volatile("v_cvt_pk_bf16_f32 %0, %1, %2" : "=v"(r) : "v"(lo), "v"(hi)); return r; }
__device__ __forceinline__ float sat8(float x) { return __builtin_amdgcn_fmed3f(x, -448.f, 448.f); }
__device__ __forceinline__ unsigned cvt4_fp8(float a, float b, float c, float d) { int r = __builtin_amdgcn_cvt_pk_fp8_f32(a, b, 0, false); r = __builtin_amdgcn_cvt_pk_fp8_f32(c, d, r, true); return (unsigned)r; }
__device__ __forceinline__ unsigned cvt4_fp8_sat(float a, float b, float c, float d) { return cvt4_fp8(sat8(a), sat8(b), sat8(c), sat8(d)); }
__device__ __forceinline__ float bf2f(unsigned short b) { return __uint_as_float(((unsigned)b) << 16); }
__device__ __forceinline__ float bflo(unsigned w) { return __uint_as_float(w << 16); }
__device__ __forceinline__ float bfhi(unsigned w) { return __uint_as_float(w & 0xffff0000u); }
__device__ __forceinline__ float wave_sum(float v) {
#pragma unroll
    for (int o = 1; o < 64; o <<= 1) v += __shfl_xor(v, o);
    return v;
}
__device__ __forceinline__ float fsilu(float x) { return x * __builtin_amdgcn_rcpf(1.f + __builtin_amdgcn_exp2f(x * -1.4426950408889634f)); }
__device__ __forceinline__ float fsigm(float x) { return __builtin_amdgcn_rcpf(1.f + __builtin_amdgcn_exp2f(x * -1.4426950408889634f)); }
__device__ __forceinline__ float fgelu_tanh(float x) { const float u = x * (0.7978845608028654f + 0.035677408136300125f * x * x); return x * __builtin_amdgcn_rcpf(1.f + __builtin_amdgcn_exp2f(u * -2.885390081777927f)); }
__device__ __forceinline__ float sinrev(float r) { return __builtin_amdgcn_sinf(r); }
__device__ __forceinline__ float cosrev(float r) { return __builtin_amdgcn_cosf(r); }

namespace pg8 {
#define PG8_LAS __attribute__((address_space(3)))
typedef unsigned short bf16_t;
constexpr int BM = 256, BK = 64, HALF = 128, HTB = HALF * BK * 2, STAGE_BYTES = 8 * HTB;
__host__ __device__ __forceinline__ int lds_byte(int r, int c) { const int st = (r >> 4) * 2 + (c >> 5), rr = r & 15, cc = c & 31, ob = rr * 64 + cc * 2; return st * 1024 + (ob ^ (((ob >> 9) & 1) << 5)); }
__host__ __device__ __forceinline__ void stage_rc(int b, int& R, int& C) { const int st = b / 1024, sb = b % 1024, swz = sb ^ (((sb >> 9) & 1) << 5); R = (st >> 1) * 16 + swz / 64; C = (st & 1) * 32 + (swz % 64) / 2; }
__host__ __device__ __forceinline__ int perm32(int rho) { const int n = rho >> 4, i = rho & 15; return 8 * (i >> 2) + 4 * n + (i & 3); }
struct Unit { int pm, pn, z; };
template <int LDA_, int LDB_, int K_, long SAZ_ = 0, long SBZ_ = 0, int ESZ_ = 2> struct Shape { static constexpr int LDA = LDA_, LDB = LDB_, K = K_, ESZ = ESZ_; static constexpr long SAZ = SAZ_, SBZ = SBZ_; };
struct Gemm { const void* A; const void* Bt; };
typedef int v8i32 __attribute__((ext_vector_type(8)));
typedef int i32x4_t __attribute__((ext_vector_type(4)));
template <class Sh, class Epi, class Sched>
__device__ __forceinline__ void gemm_phase(PG8_LAS unsigned char* lds, const Gemm g, const Sched& S, const Epi& E) {
    int tid = threadIdx.x; asm volatile("" : "+v"(tid));
    const int wid = __builtin_amdgcn_readfirstlane(tid >> 6), lane = tid & 63, wr = wid >> 2, wc = wid & 3, fr = lane & 15, fq = lane >> 4;
    constexpr int nt = Sh::K * Sh::ESZ / 128;
    unsigned voffA[2], voffB[2];
#pragma unroll
    for (int i = 0; i < 2; ++i) { int R, C; stage_rc(tid * 16 + i * 8192, R, C); const int Rb = Epi::PERM ? ((R & ~31) + perm32(R & 31)) : R;
        voffA[i] = (unsigned)(R * Sh::LDA * Sh::ESZ + C * 2); voffB[i] = (unsigned)(Rb * Sh::LDB * Sh::ESZ + C * 2); }
    const size_t kstep = (size_t)(BK * 2);
    constexpr size_t hsA = (size_t)HALF * Sh::LDA * Sh::ESZ, hsB = (size_t)HALF * Sh::LDB * Sh::ESZ;
    const unsigned ldsw = (unsigned)wid * 1024u;
    const int aoff = lds_byte(wr * 64 + fr, fq * 8), boff = lds_byte(wc * 32 + fr, fq * 8);
#define PG8_TA(u) ((const char*)g.A + ((size_t)(u).z * (size_t)Sh::SAZ + (size_t)(u).pm * BM * Sh::LDA) * Sh::ESZ)
#define PG8_TB(u) ((const char*)g.Bt + ((size_t)(u).z * (size_t)Sh::SBZ + (size_t)(u).pn * BM * Sh::LDB) * Sh::ESZ)
#define PG8_SA(b, h) (((b) * 2 + (h)) * HTB)
#define PG8_SB(b, h) ((4 + (b) * 2 + (h)) * HTB)
#define PG8_STAGE(bufoff, gbase, voff) do { _Pragma("unroll") for (int _i = 0; _i < 2; ++_i) \
        __builtin_amdgcn_global_load_lds((const unsigned*)((const char*)(gbase) + (voff)[_i]), (PG8_LAS unsigned*)(lds + (bufoff) + ldsw + _i * 8192), 16, 0, 0); } while (0)
#define PG8_LD8(p) __builtin_shufflevector(*(const PG8_LAS i32x4_t*)(p), *(const PG8_LAS i32x4_t*)((p) + 1024), 0, 1, 2, 3, 4, 5, 6, 7)
#define PG8_LDA(dst, b, h) do { _Pragma("unroll") for (int m = 0; m < 4; ++m) dst[m] = PG8_LD8(lds + PG8_SA(b, h) + aoff + m * 2048); } while (0)
#define PG8_LDB(dst, b, h) do { _Pragma("unroll") for (int n = 0; n < 2; ++n) dst[n] = PG8_LD8(lds + PG8_SB(b, h) + boff + n * 2048); } while (0)
#define PG8_LO(x) __builtin_bit_cast(bf16x8, __builtin_shufflevector((x), (x), 0, 1, 2, 3))
#define PG8_HI(x) __builtin_bit_cast(bf16x8, __builtin_shufflevector((x), (x), 4, 5, 6, 7))
#define PG8_MMA(ai, bj, At, Bt) do { __builtin_amdgcn_s_setprio(1); \
        if constexpr (Sh::ESZ == 1) { _Pragma("unroll") for (int m = 0; m < 4; ++m) _Pragma("unroll") for (int n = 0; n < 2; ++n) \
            asm volatile("v_mfma_scale_f32_16x16x128_f8f6f4 %0, %1, %2, %0, %3, %3 op_sel_hi:[0,0,0]" : "+v"(acc[ai][bj][m][n]) : "v"(Bt[n]), "v"(At[m]), "v"(sc127)); } \
        else { _Pragma("unroll") for (int m = 0; m < 4; ++m) _Pragma("unroll") for (int n = 0; n < 2; ++n) { \
            acc[ai][bj][m][n] = __builtin_amdgcn_mfma_f32_16x16x32_bf16(PG8_LO(Bt[n]), PG8_LO(At[m]), acc[ai][bj][m][n], 0, 0, 0); \
            acc[ai][bj][m][n] = __builtin_amdgcn_mfma_f32_16x16x32_bf16(PG8_HI(Bt[n]), PG8_HI(At[m]), acc[ai][bj][m][n], 0, 0, 0); } } \
        __builtin_amdgcn_s_setprio(0); } while (0)
#define PG8_WAIT_V(n) asm volatile("s_waitcnt vmcnt(" #n ")" ::: "memory")
#define PG8_WAIT_L(n) asm volatile("s_waitcnt lgkmcnt(" #n ")" ::: "memory")
#define PG8_BAR __builtin_amdgcn_s_barrier()
#define PG8_SCHED __builtin_amdgcn_sched_barrier(0)
    Unit cur, nxt; int ui = 0;
    if (!S.next(0, cur)) return;
    f32x4 acc[2][2][4][2];
#pragma unroll
    for (int a = 0; a < 2; ++a)
#pragma unroll
        for (int b = 0; b < 2; ++b)
#pragma unroll
            for (int m = 0; m < 4; ++m)
#pragma unroll
                for (int n = 0; n < 2; ++n) acc[a][b][m][n] = (f32x4){0.f, 0.f, 0.f, 0.f};
    v8i32 At[4], B0[2], B1[2]; int sc127 = 0x7f7f7f7f; asm volatile("" : "+v"(sc127));
    const char* cA = PG8_TA(cur); const char* cB = PG8_TB(cur);
    PG8_STAGE(PG8_SB(0, 0), cB, voffB); PG8_STAGE(PG8_SB(0, 1), cB + hsB, voffB); PG8_STAGE(PG8_SA(0, 0), cA, voffA); PG8_STAGE(PG8_SA(0, 1), cA + hsA, voffA);
    if (wr == 1) PG8_BAR;
    PG8_WAIT_V(2); PG8_BAR;
    PG8_STAGE(PG8_SB(1, 0), cB + kstep, voffB); PG8_STAGE(PG8_SA(1, 0), cA + kstep, voffA); PG8_STAGE(PG8_SB(1, 1), cB + hsB + kstep, voffB);
    PG8_WAIT_V(6); PG8_BAR;
    for (;;) {
        const bool has_next = S.next(ui + 1, nxt);
        const char* nA = has_next ? PG8_TA(nxt) : cA; const char* nB = has_next ? PG8_TB(nxt) : cB;
#pragma nounroll
        for (int t = 0; t < nt; t += 2) {
            const bool last = (t == nt - 2);
            const char* a1 = cA + (size_t)(t + 1) * kstep;
            const char* a2 = last ? nA : cA + (size_t)(t + 2) * kstep; const char* b2 = last ? nB : cB + (size_t)(t + 2) * kstep;
            const char* a3 = a2 + kstep; const char* b3 = b2 + kstep;
            PG8_LDB(B0, 0, 0); PG8_LDB(B1, 0, 1); PG8_SCHED; PG8_LDA(At, 0, 0); PG8_STAGE(PG8_SA(1, 1), a1 + hsA, voffA);
            PG8_WAIT_V(8); PG8_WAIT_L(0); PG8_BAR; PG8_MMA(0, 0, At, B0); PG8_MMA(0, 1, At, B1); PG8_BAR; PG8_SCHED;
            PG8_LDA(At, 0, 1); PG8_STAGE(PG8_SB(0, 0), b2, voffB); PG8_STAGE(PG8_SB(0, 1), b2 + hsB, voffB); PG8_STAGE(PG8_SA(0, 0), a2, voffA);
            PG8_WAIT_V(8); PG8_WAIT_L(0); PG8_BAR; PG8_MMA(1, 0, At, B0); PG8_MMA(1, 1, At, B1); PG8_BAR; PG8_SCHED;
            PG8_LDB(B0, 1, 0); PG8_LDB(B1, 1, 1); PG8_SCHED; PG8_LDA(At, 1, 0); PG8_STAGE(PG8_SA(0, 1), a2 + hsA, voffA);
            PG8_WAIT_V(8); PG8_WAIT_L(0); PG8_BAR; PG8_MMA(0, 0, At, B0); PG8_MMA(0, 1, At, B1); PG8_BAR; PG8_SCHED;
            PG8_LDA(At, 1, 1); PG8_STAGE(PG8_SB(1, 0), b3, voffB); PG8_STAGE(PG8_SB(1, 1), b3 + hsB, voffB); PG8_STAGE(PG8_SA(1, 0), a3, voffA);
            PG8_WAIT_V(8); PG8_WAIT_L(0); PG8_BAR; PG8_MMA(1, 0, At, B0); PG8_MMA(1, 1, At, B1); PG8_BAR; PG8_SCHED;
        }
        if (wr == 0) PG8_BAR;
        if constexpr (Sh::ESZ == 1) asm volatile("s_nop 15\n\ts_nop 15" ::: "memory");
        E(acc, cur, wr, wc, fr, fq);
        if (!has_next) break;
#pragma unroll
        for (int a = 0; a < 2; ++a)
#pragma unroll
            for (int b = 0; b < 2; ++b)
#pragma unroll
                for (int m = 0; m < 4; ++m)
#pragma unroll
                    for (int n = 0; n < 2; ++n) acc[a][b][m][n] = (f32x4){0.f, 0.f, 0.f, 0.f};
        cur = nxt; cA = nA; cB = nB; ++ui;
        if (wr == 1) PG8_BAR;
    }
    PG8_WAIT_V(0);
    PG8_BAR;
#undef PG8_TA
#undef PG8_TB
#undef PG8_SA
#undef PG8_SB
#undef PG8_STAGE
#undef PG8_LDA
#undef PG8_LDB
#undef PG8_MMA
#undef PG8_LD8
#undef PG8_LO
#undef PG8_HI
#undef PG8_WAIT_V
#undef PG8_WAIT_L
#undef PG8_BAR
#undef PG8_SCHED
}
}

template <class Dec> struct ListOrder {
    int n, G, c; Dec dec;
    __device__ __forceinline__ bool next(int i, pg8::Unit& u) const { const long L = (long)i * G + c; if (c < 0 || L >= n) return false; dec((int)L, u); return true; }
};
__device__ __forceinline__ int lat_tile(int i) { return (i >> 3) * 9 + 1 + (i & 7); }
struct Dec2D {
    int nM, nN, latM, latN;
    __device__ __forceinline__ void operator()(int L, pg8::Unit& u) const {
        const int nwg = nM * nN; int wgid = L; { const int q = nwg / 8, r = nwg % 8, xcd = wgid % 8, off = wgid / 8; wgid = (xcd < r ? xcd * (q + 1) : r * (q + 1) + (xcd - r) * q) + off; }
        const int nig = 8 * nN, gid = wgid / nig, fm = gid * 8, gsz = (nM - fm) < 8 ? (nM - fm) : 8;
        int pm = fm + ((wgid % nig) % gsz), pn = (wgid % nig) / gsz;
        if (latM) pm = lat_tile(pm); if (latN) pn = lat_tile(pn);
        u.pm = pm; u.pn = pn; u.z = 0;
    }
};
struct DecWin1 {
    __device__ __forceinline__ void operator()(int L, pg8::Unit& u) const { if (L < 896) { Dec2D d{128, 7, 1, 0}; d(L, u); } else { const int r = L - 896; u.pm = (r / 5) * 9; u.pn = 2 + r % 5; u.z = 0; } } };
struct DecCtxK {
    __device__ __forceinline__ void operator()(int L, pg8::Unit& u) const { u.z = L >> 6; const int r = L & 63; u.pm = (r >> 2) * 9; u.pn = r & 3; } };
struct DecBatch { int nM, nN;
    __device__ __forceinline__ void operator()(int L, pg8::Unit& u) const { const int per = nM * nN; u.z = L / per; const int r = L % per; u.pm = r % nM; u.pn = r / nM; } };
struct DecMoe { int p0, np, nN; int pe[NEXP];
    __device__ __forceinline__ void operator()(int L, pg8::Unit& u) const {
        const int nig = 8 * nN, gid = L / nig, fm = gid * 8, gsz = (np - fm) < 8 ? (np - fm) : 8;
        const int pm = p0 + fm + ((L % nig) % gsz); u.pm = pm; u.pn = (L % nig) / gsz; int z = 0;
#pragma unroll
        for (int e = 0; e < NEXP - 1; ++e) z += (pm >= pe[e]) ? 1 : 0;
        u.z = z;
    }
};

typedef const f32x4 (&AccRef)[2][2][4][2];
#define EPI_LOOP_AM for (int ai = 0; ai < 2; ++ai) _Pragma("unroll") for (int m = 0; m < 4; ++m)
__device__ __forceinline__ u32x4 pack8(f32x4 v0, f32x4 v1) { u32x4 w; w.x = cvt_pk_bf16(v0[0], v0[1]); w.y = cvt_pk_bf16(v0[2], v0[3]); w.z = cvt_pk_bf16(v1[0], v1[1]); w.w = cvt_pk_bf16(v1[2], v1[3]); return w; }

template <size_t OFF, int LDC> struct EpiPlain {
    static constexpr bool PERM = true;
    unsigned char* ws;
    __device__ __forceinline__ void operator()(AccRef acc, const pg8::Unit& u, int wr, int wc, int fr, int fq) const {
        const int row0 = u.pm * 256 + wr * 64 + fr, col0 = u.pn * 256 + wc * 32 + 8 * fq; bf16* base = (bf16*)(ws + OFF);
#pragma unroll
        EPI_LOOP_AM { bf16* rowp = base + (size_t)(row0 + ai * 128 + m * 16) * LDC + col0;
#pragma unroll
            for (int bj = 0; bj < 2; ++bj) *(u32x4*)(rowp + bj * 128) = pack8(acc[ai][bj][m][0], acc[ai][bj][m][1]); }
    }
};
struct EpiCtxPart {
    static constexpr bool PERM = true;
    unsigned char* ws;
    __device__ __forceinline__ void operator()(AccRef acc, const pg8::Unit& u, int wr, int wc, int fr, int fq) const {
        const int row0 = (u.pm / 9) * 256 + wr * 64 + fr, col0 = u.pn * 256 + wc * 32 + 8 * fq; bf16* base = (bf16*)(ws + WS_CPART) + (size_t)u.z * 4096 * 1024;
#pragma unroll
        EPI_LOOP_AM { bf16* rowp = base + (size_t)(row0 + ai * 128 + m * 16) * 1024 + col0;
#pragma unroll
            for (int bj = 0; bj < 2; ++bj) *(u32x4*)(rowp + bj * 128) = pack8(acc[ai][bj][m][0], acc[ai][bj][m][1]); }
    }
};
template <size_t OFF, int LDC, long SZ> struct EpiF32z {
    static constexpr bool PERM = false;
    unsigned char* ws;
    __device__ __forceinline__ void operator()(AccRef acc, const pg8::Unit& u, int wr, int wc, int fr, int fq) const {
        const int row0 = u.pm * 256 + wr * 64 + fr, col0 = u.pn * 256 + wc * 32 + 4 * fq; float* base = (float*)(ws + OFF) + (size_t)u.z * SZ;
#pragma unroll
        EPI_LOOP_AM { float* rowp = base + (size_t)(row0 + ai * 128 + m * 16) * LDC + col0;
#pragma unroll
            for (int bj = 0; bj < 2; ++bj)
#pragma unroll
                for (int n = 0; n < 2; ++n) *(f32x4*)(rowp + bj * 128 + n * 16) = acc[ai][bj][m][n]; }
    }
};
struct EpiIn {
    static constexpr bool PERM = true;
    unsigned char* ws;
    __device__ __forceinline__ void operator()(AccRef acc, const pg8::Unit& u, int wr, int wc, int fr, int fq) const {
        const int b = u.pm / 9, j9 = u.pm % 9;
        if (u.pn < 4) {
            bf16* O = (bf16*)(ws + ((u.pn < 2) ? WS_Q : WS_K)); const float* rope = (const float*)(ws + WS_ROPE); const int colb = (u.pn & 1) * 256 + wc * 32 + 8 * fq; const bool rot = (j9 != 0); const int hsel = wc & 1;
#pragma unroll
            EPI_LOOP_AM { const int rl = ai * 128 + wr * 64 + m * 16 + fr; const int pos = hsel ? (m * 16 + fr) : ((j9 - 1) * 4 + 2 * ai + wr);
                f32x4 cs0 = (f32x4){1.f, 0.f, 1.f, 0.f}, cs1 = cs0;
                if (rot) { const f32x4* tp = (const f32x4*)(rope + (size_t)(pos * 16 + 4 * fq) * 2); cs0 = tp[0]; cs1 = tp[1]; }
                bf16* rowp = O + (size_t)(u.pm * 256 + rl) * 512 + colb; const float qs = (u.pn < 2) ? 0.18033688011112042f : 1.f;
#pragma unroll
                for (int bj = 0; bj < 2; ++bj) { const f32x4 a0 = acc[ai][bj][m][0] * qs, a1 = acc[ai][bj][m][1] * qs; f32x4 o0, o1;
                    o0[0] = a0[0] * cs0[0] - a0[1] * cs0[1]; o0[1] = a0[1] * cs0[0] + a0[0] * cs0[1];
                    o0[2] = a0[2] * cs0[2] - a0[3] * cs0[3]; o0[3] = a0[3] * cs0[2] + a0[2] * cs0[3];
                    o1[0] = a1[0] * cs1[0] - a1[1] * cs1[1]; o1[1] = a1[1] * cs1[0] + a1[0] * cs1[1];
                    o1[2] = a1[2] * cs1[2] - a1[3] * cs1[3]; o1[3] = a1[3] * cs1[2] + a1[2] * cs1[3];
                    *(u32x4*)(rowp + bj * 128) = pack8(o0, o1); } }
        } else if (u.pn < 6) {
            const int colb = (u.pn - 4) * 256 + wc * 32 + 8 * fq;
#pragma unroll
            EPI_LOOP_AM { bf16* rowp = (bf16*)(ws + WS_V) + (size_t)(u.pm * 256 + ai * 128 + wr * 64 + m * 16 + fr) * 512 + colb;
#pragma unroll
                for (int bj = 0; bj < 2; ++bj) *(u32x4*)(rowp + bj * 128) = pack8(acc[ai][bj][m][0], acc[ai][bj][m][1]); }
        } else {
#pragma unroll
            EPI_LOOP_AM { const int chunk = b * NCH + j9 * 16 + 8 * ai + 4 * wr + m, tl = fr;
#pragma unroll
                for (int bj = 0; bj < 2; ++bj) { const int c = bj * 128 + wc * 32 + 8 * fq, gi = c >> 4, ch = c & 15;
                    *(u32x4*)((bf16*)(ws + WS_UA) + ((size_t)gi * S5ROWS + chunk) * S5K2 + tl * 16 + ch) = pack8(acc[ai][bj][m][0], acc[ai][bj][m][1]); } }
        }
    }
};
struct EpiFT {
    static constexpr bool PERM = true;
    unsigned char* ws;
    __device__ __forceinline__ void operator()(AccRef acc, const pg8::Unit& u, int wr, int wc, int fr, int fq) const {
        const int cs = u.pm, b = u.pn / 9, j9 = u.pn % 9;
#pragma unroll
        EPI_LOOP_AM { const int ch = ai * 128 + wr * 64 + m * 16 + fr;
#pragma unroll
            for (int bj = 0; bj < 2; ++bj) { const int tc = bj * 128 + wc * 32 + 8 * fq;
                bf16* p = (j9 == 0) ? (bf16*)(ws + WS_FTC) + ((size_t)(b * 256 + ch) * 512 + cs * 256 + tc) : (bf16*)(ws + WS_FT2) + ((size_t)(b * 256 + ch) * 4096 + cs * 2048 + (j9 - 1) * 256 + tc);
                *(u32x4*)p = pack8(acc[ai][bj][m][0], acc[ai][bj][m][1]); } }
    }
};
struct EpiDft {
    static constexpr bool PERM = true;
    unsigned char* ws; int row_off;
    __device__ __forceinline__ void operator()(AccRef acc, const pg8::Unit& u, int wr, int wc, int fr, int fq) const {
#pragma unroll
        EPI_LOOP_AM { const int k = u.pm * 256 + ai * 128 + wr * 64 + m * 16 + fr; bf16* rowp = (bf16*)(ws + WS_CAT) + (size_t)(u.pn * SA + row_off + k) * 1024 + 512 + wc * 32 + 8 * fq;
#pragma unroll
            for (int bj = 0; bj < 2; ++bj) *(u32x4*)(rowp + bj * 128) = pack8(acc[ai][bj][m][0], acc[ai][bj][m][1]); }
    }
};
struct EpiS5 {
    static constexpr bool PERM = true;
    unsigned char* ws; const float* Dv; int lat_only;
    __device__ __forceinline__ void operator()(AccRef acc, const pg8::Unit& u, int wr, int wc, int fr, int fq) const {
        const int ch0 = 8 * (fq & 1); f32x4 d0 = *(const f32x4*)(Dv + u.z * 16 + ch0), d1 = *(const f32x4*)(Dv + u.z * 16 + ch0 + 4);
#pragma unroll
        EPI_LOOP_AM { const int row = u.pm * 256 + ai * 128 + wr * 64 + m * 16 + fr; const int b = row / NCH, c = row % NCH;
            if (!(lat_only && c < CT / CHT)) {
#pragma unroll
                for (int bj = 0; bj < 2; ++bj) { const int n2 = u.pn * 256 + bj * 128 + wc * 32 + 8 * fq, tl = n2 >> 4;
                    const u32x4 uw = *(const u32x4*)((const bf16*)(ws + WS_UA) + ((size_t)u.z * S5ROWS + row) * S5K2 + n2);
                    f32x4 v0 = acc[ai][bj][m][0], v1 = acc[ai][bj][m][1];
                    v0[0] += d0[0] * bflo(uw.x); v0[1] += d0[1] * bfhi(uw.x); v0[2] += d0[2] * bflo(uw.y); v0[3] += d0[3] * bfhi(uw.y);
                    v1[0] += d1[0] * bflo(uw.z); v1[1] += d1[1] * bfhi(uw.z); v1[2] += d1[2] * bflo(uw.w); v1[3] += d1[3] * bfhi(uw.w);
#pragma unroll
                    for (int e = 0; e < 4; ++e) { v0[e] = fgelu_tanh(v0[e]); v1[e] = fgelu_tanh(v1[e]); }
                    *(u32x4*)((bf16*)(ws + WS_YY) + (size_t)(b * SA + c * CHT + tl) * 256 + u.z * 16 + ch0) = pack8(v0, v1); } }
            asm volatile("" ::: "memory"); }
    }
};
struct EpiGlu {
    static constexpr bool PERM = true;
    unsigned char* ws;
    __device__ __forceinline__ void operator()(AccRef acc, const pg8::Unit& u, int wr, int wc, int fr, int fq) const {
#pragma unroll
        EPI_LOOP_AM { const size_t row = (size_t)(u.pm * 256 + ai * 128 + wr * 64 + m * 16 + fr);
#pragma unroll
            for (int bj = 0; bj < 2; ++bj) { const int n = bj * 128 + wc * 32 + 8 * fq; const u32x4 yw = *(const u32x4*)((const bf16*)(ws + WS_YY) + row * 256 + n);
                const f32x4 a0 = acc[ai][bj][m][0], a1 = acc[ai][bj][m][1]; f32x4 v0, v1;
                v0[0] = bflo(yw.x) * fsigm(a0[0]); v0[1] = bfhi(yw.x) * fsigm(a0[1]); v0[2] = bflo(yw.y) * fsigm(a0[2]); v0[3] = bfhi(yw.y) * fsigm(a0[3]);
                v1[0] = bflo(yw.z) * fsigm(a1[0]); v1[1] = bfhi(yw.z) * fsigm(a1[1]); v1[2] = bflo(yw.w) * fsigm(a1[2]); v1[3] = bfhi(yw.w) * fsigm(a1[3]);
                *(u32x4*)((bf16*)(ws + WS_CAT) + row * 1024 + 768 + n) = pack8(v0, v1); }
            asm volatile("" ::: "memory"); }
    }
};
template <size_t OFF, int LDH> struct EpiSwiGLU {
    static constexpr bool PERM = true;
    unsigned char* ws; int pm0; float si;
    __device__ __forceinline__ void operator()(AccRef acc, const pg8::Unit& u, int wr, int wc, int fr, int fq) const {
#pragma unroll
        EPI_LOOP_AM { const size_t row = (size_t)((u.pm - pm0) * 256 + ai * 128 + wr * 64 + m * 16 + fr); f32x4 v0, v1;
#pragma unroll
            for (int e = 0; e < 4; ++e) { v0[e] = fsilu(acc[ai][0][m][0][e] * si) * (acc[ai][1][m][0][e] * si); v1[e] = fsilu(acc[ai][0][m][1][e] * si) * (acc[ai][1][m][1][e] * si); }
            *(u32x4*)((bf16*)(ws + OFF) + row * LDH + u.pn * 128 + wc * 32 + 8 * fq) = pack8(v0, v1); }
    }
};
template <size_t OFF, int LDH> struct EpiSwiGLU8 {
    static constexpr bool PERM = true;
    unsigned char* ws;
    __device__ __forceinline__ void operator()(AccRef acc, const pg8::Unit& u, int wr, int wc, int fr, int fq) const {
        constexpr float si = 1.f / (MOE_AS * MOE_WS);
#pragma unroll
        EPI_LOOP_AM { const size_t row = (size_t)(u.pm * 256 + ai * 128 + wr * 64 + m * 16 + fr); float v[8];
#pragma unroll
            for (int e = 0; e < 4; ++e) { v[e] = fsilu(acc[ai][0][m][0][e] * si) * (acc[ai][1][m][0][e] * (si * MOE_HS)); v[4 + e] = fsilu(acc[ai][0][m][1][e] * si) * (acc[ai][1][m][1][e] * (si * MOE_HS)); }
            u32x2 o; o.x = cvt4_fp8_sat(v[0], v[1], v[2], v[3]); o.y = cvt4_fp8_sat(v[4], v[5], v[6], v[7]);
            *(u32x2*)(ws + OFF + row * LDH + u.pn * 128 + wc * 32 + 8 * fq) = o; }
    }
};
struct EpiMoeDown {
    static constexpr bool PERM = true;
    unsigned char* ws; int part;
    __device__ __forceinline__ void operator()(AccRef acc, const pg8::Unit& u, int wr, int wc, int fr, int fq) const {
        const int row0 = u.pm * 256 + wr * 64 + fr, col0 = u.pn * 256 + wc * 32 + 8 * fq;
        constexpr float so = 1.f / (MOE_HS * MOE_WS);
        bf16* yb = part < 0 ? (bf16*)(ws + WS_Y) : (bf16*)(ws + WS_Y2) + (size_t)part * 2048 * 1024 - (size_t)65536 * 1024;
#pragma unroll
        EPI_LOOP_AM { bf16* rowp = yb + (size_t)(row0 + ai * 128 + m * 16) * 1024 + col0;
#pragma unroll
            for (int bj = 0; bj < 2; ++bj) *(u32x4*)(rowp + bj * 128) = pack8(acc[ai][bj][m][0] * so, acc[ai][bj][m][1] * so); }
    }
};

namespace att {
constexpr int NW = 8, QBLK = 32, KVBLK = 64;
constexpr float SCALE = 0.125f, THR = 16.f;
constexpr int LDQ = 512, LDK = 512, LDV = 512, LDO = 1024;
constexpr int NSLOT = 2, SHM_V = KVBLK * 128 * 2, SHM_K = KVBLK * 64 * 2, SHM_ATTN = NSLOT * SHM_V + NSLOT * SHM_K + NW * 64 * 4;
#define KSWZ(row, colB) ((row) * 128 + ((colB) ^ ((((row) >> 1) & 7) << 4)))
#define SBAR() __builtin_amdgcn_sched_barrier(0)
__device__ __forceinline__ int crow(int r, int hi) { return (r & 3) + 8 * (r >> 2) + 4 * hi; }
template <bool FIRST> __device__ __forceinline__ void partialSM(f32x16& p0, f32x16& p1, float& m_reg, f32x16& negm, float& alpha) {
    constexpr float THR2 = THR * 1.4426950408889634f;
    float pmax = p0[0];
#pragma unroll
    for (int r = 1; r < 16; ++r) pmax = fmaxf(pmax, p0[r]);
#pragma unroll
    for (int r = 0; r < 16; ++r) pmax = fmaxf(pmax, p1[r]);
    { auto rr = __builtin_amdgcn_permlane32_swap(__float_as_uint(pmax), __float_as_uint(pmax), false, false);
      pmax = fmaxf(__uint_as_float(rr[0]), __uint_as_float(rr[1])); }
    alpha = 1.f;
    if (FIRST || __builtin_expect(__any(pmax > THR2), 0)) {
        const float dl = FIRST ? pmax : fmaxf(pmax, 0.f); m_reg += dl; alpha = __builtin_amdgcn_exp2f(-dl);
#pragma unroll
        for (int r = 0; r < 16; ++r) { p0[r] -= dl; p1[r] -= dl; }
#pragma unroll
        for (int r = 0; r < 16; ++r) negm[r] = -m_reg;
        asm volatile("" : "+v"(negm));
    }
#pragma unroll
    for (int r = 0; r < 16; ++r) p0[r] = __builtin_amdgcn_exp2f(p0[r]);
}
__device__ __forceinline__ void finishSM(f32x16& p0, f32x16& p1, float alpha, float& l_reg, bf16x8& pa0, bf16x8& pa1, bf16x8& pa2, bf16x8& pa3) {
#pragma unroll
    for (int r = 0; r < 16; ++r) p1[r] = __builtin_amdgcn_exp2f(p1[r]);
    float ps = 0;
#pragma unroll
    for (int r = 0; r < 16; ++r) ps += p0[r];
#pragma unroll
    for (int r = 0; r < 16; ++r) ps += p1[r];
    { auto rr = __builtin_amdgcn_permlane32_swap(__float_as_uint(ps), __float_as_uint(ps), false, false);
      ps = __uint_as_float(rr[0]) + __uint_as_float(rr[1]); }
    l_reg = l_reg * alpha + ps;
#define PK4(P, BASE, OUT) do { unsigned a0 = cvt_pk_bf16(P[BASE + 0], P[BASE + 1]), a1 = cvt_pk_bf16(P[BASE + 2], P[BASE + 3]);   \
    unsigned b0 = cvt_pk_bf16(P[BASE + 4], P[BASE + 5]), b1 = cvt_pk_bf16(P[BASE + 6], P[BASE + 7]);                              \
    auto r0 = __builtin_amdgcn_permlane32_swap(a0, b0, false, false); auto r1 = __builtin_amdgcn_permlane32_swap(a1, b1, false, false); \
    u32x4 w = {r0[0], r1[0], r0[1], r1[1]}; OUT = *reinterpret_cast<bf16x8*>(&w); } while (0)
    PK4(p0, 0, pa0); PK4(p0, 8, pa1); PK4(p1, 0, pa2); PK4(p1, 8, pa3);
#undef PK4
}
__device__ __forceinline__ void qkt(f32x16& p0, f32x16& p1, const char* Ks, const bf16x8* qr, const f32x16& negm, int r32, int hi) {
    p0 = negm; p1 = negm;
#pragma unroll
    for (int d0 = 0; d0 < 4; ++d0) { const int cb = d0 * 32 + hi * 16;
        const bf16x8 b0 = *reinterpret_cast<const bf16x8*>(Ks + KSWZ(r32, cb));
        const bf16x8 b1 = *reinterpret_cast<const bf16x8*>(Ks + KSWZ(32 + r32, cb));
        p0 = __builtin_amdgcn_mfma_f32_32x32x16_bf16(b0, qr[d0], p0, 0, 0, 0);
        p1 = __builtin_amdgcn_mfma_f32_32x32x16_bf16(b1, qr[d0], p1, 0, 0, 0); }
}
__device__ __forceinline__ int v_st(int k, int c) { const int kk = (k & ~0xC) | ((k & 4) << 1) | ((k & 8) >> 1); return ((kk >> 3) * 4 + (c >> 5)) * 512 + ((kk & 7) * 32 + (c & 31)) * 2; }
__device__ __forceinline__ int v_rd_base(int lane) { return ((lane & 3) << 3) | (((lane >> 2) & 3) << 6) | (((lane >> 4) & 1) << 5) | (((lane >> 5) & 1) << 8); }
constexpr int v_rd_off(int d0, int ks, int half) { return d0 * 512 + ks * 4096 + half * 2048; }
typedef short v4i16_t __attribute__((ext_vector_type(4)));
typedef const __attribute__((address_space(3))) char* lds_cptr;
template <int OFF> __device__ __forceinline__ s16x4 tr_read(lds_cptr vb) { return __builtin_bit_cast(s16x4, __builtin_amdgcn_ds_read_tr16_b64_v4i16((__attribute__((address_space(3))) v4i16_t*)(vb + OFF))); }
template <int D0> __device__ __forceinline__ void pv_one(f32x16& od, lds_cptr vb, bf16x8 pa0, bf16x8 pa1, bf16x8 pa2, bf16x8 pa3) {
    const s16x4 l0 = tr_read<v_rd_off(D0, 0, 0)>(vb), h0 = tr_read<v_rd_off(D0, 0, 1)>(vb), l1 = tr_read<v_rd_off(D0, 1, 0)>(vb), h1 = tr_read<v_rd_off(D0, 1, 1)>(vb);
    const s16x4 l2 = tr_read<v_rd_off(D0, 2, 0)>(vb), h2 = tr_read<v_rd_off(D0, 2, 1)>(vb), l3 = tr_read<v_rd_off(D0, 3, 0)>(vb), h3 = tr_read<v_rd_off(D0, 3, 1)>(vb);
#define PK(L, H) (bf16x8){L[0], L[1], L[2], L[3], H[0], H[1], H[2], H[3]}
    od = __builtin_amdgcn_mfma_f32_32x32x16_bf16(pa0, PK(l0, h0), od, 0, 0, 0);
    od = __builtin_amdgcn_mfma_f32_32x32x16_bf16(pa1, PK(l1, h1), od, 0, 0, 0);
    od = __builtin_amdgcn_mfma_f32_32x32x16_bf16(pa2, PK(l2, h2), od, 0, 0, 0);
    od = __builtin_amdgcn_mfma_f32_32x32x16_bf16(pa3, PK(l3, h3), od, 0, 0, 0);
#undef PK
}
__device__ __forceinline__ void pv_d0(f32x16* o, lds_cptr vb, bf16x8 pa0, bf16x8 pa1, bf16x8 pa2, bf16x8 pa3) {
    pv_one<0>(o[0], vb, pa0, pa1, pa2, pa3); pv_one<1>(o[1], vb, pa0, pa1, pa2, pa3); pv_one<2>(o[2], vb, pa0, pa1, pa2, pa3); pv_one<3>(o[3], vb, pa0, pa1, pa2, pa3);
}
__device__ __forceinline__ void attn_unit(const bf16* __restrict__ Qb, const bf16* __restrict__ Kh, const bf16* __restrict__ Vh, bf16* __restrict__ Ob, int seq, char* lds) {
    int tid = threadIdx.x; asm volatile("" : "+v"(tid));
    const int wid = tid >> 6, lane = tid & 63, r32 = lane & 31, hi = lane >> 5;
    char* V_lds = lds; char* K_lds = lds + NSLOT * SHM_V;
    float* ws = (float*)(lds + NSLOT * SHM_V + NSLOT * SHM_K) + wid * 64; float* li_l = ws; float* al_l = ws + 32;
    float m_reg = 0.f, l_reg = 0; f32x16 o[4] = {}; bf16x8 qr[4]; f32x16 negm = f32x16{}; asm volatile("" : "+v"(negm));
    const bf16* Qw = Qb + (long)(wid * QBLK + r32) * LDQ + hi * 8;
#pragma unroll
    for (int d0 = 0; d0 < 4; ++d0) qr[d0] = *reinterpret_cast<const bf16x8*>(Qw + d0 * 16);
    const int sr = tid >> 4, sc = (tid & 15) * 8, vst0 = v_st(sr, sc), vst1 = v_st(32 + sr, sc);
    const int kr = tid >> 3, kc = (tid & 7) * 8, kst = KSWZ(kr, kc * 2);
    const lds_cptr vb0 = (lds_cptr)V_lds + v_rd_base(lane);
    struct { bf16x8 vs0, vs1, ks; } sr_[2];
#define SLOAD(i, k0) do { sr_[i].vs0 = *reinterpret_cast<const bf16x8*>(&Vh[(long)((k0) + sr) * LDV + sc]); sr_[i].vs1 = *reinterpret_cast<const bf16x8*>(&Vh[(long)((k0) + 32 + sr) * LDV + sc]); \
    sr_[i].ks = *reinterpret_cast<const bf16x8*>(&Kh[(long)((k0) + kr) * LDK + kc]); } while (0)
#define SWRITE(b, i) do { *(bf16x8*)(V_lds + (b) * SHM_V + vst0) = sr_[i].vs0; *(bf16x8*)(V_lds + (b) * SHM_V + vst1) = sr_[i].vs1; \
    *(bf16x8*)(K_lds + (b) * SHM_K + kst) = sr_[i].ks; } while (0)
#define SWAIT() asm volatile("s_waitcnt vmcnt(3)" ::: "memory")
#define RESC(a) do { if (__any((a) < 1.f)) { if (hi == 0) al_l[r32] = (a); asm volatile("s_waitcnt lgkmcnt(0)" ::: "memory"); \
    _Pragma("unroll") for (int d = 0; d < 4; ++d) _Pragma("unroll") for (int r = 0; r < 16; ++r) o[d][r] *= al_l[crow(r, hi)]; } } while (0)
    f32x16 pA0, pA1, pB0, pB1; float alA, alB; bf16x8 pa0, pa1, pa2, pa3; const int NT = seq / KVBLK;
    constexpr int SE = 0, SO = 1;
    SLOAD(SE, 0); asm volatile("s_waitcnt vmcnt(0)" ::: "memory"); SWRITE(0, SE); __syncthreads();
    qkt(pA0, pA1, K_lds, qr, negm, r32, hi); partialSM<true>(pA0, pA1, m_reg, negm, alA);
    SLOAD(SO, KVBLK); if (2 < NT) SLOAD(SE, 2 * KVBLK);
    SWAIT(); SWRITE(1, SO); __syncthreads();
    for (int j = 1; j + 1 < NT; j += 2) {
        SBAR(); qkt(pB0, pB1, K_lds + SHM_K, qr, negm, r32, hi);
        finishSM(pA0, pA1, alA, l_reg, pa0, pa1, pa2, pa3); SBAR();
        SLOAD(SO, (j + 2) * KVBLK); SBAR();
        pv_d0(o, vb0, pa0, pa1, pa2, pa3); partialSM<false>(pB0, pB1, m_reg, negm, alB);
        __syncthreads(); SWAIT(); SWRITE(0, SE);
        RESC(alB); __syncthreads();
        SBAR(); qkt(pA0, pA1, K_lds, qr, negm, r32, hi);
        finishSM(pB0, pB1, alB, l_reg, pa0, pa1, pa2, pa3); SBAR();
        if (j + 3 < NT) SLOAD(SE, (j + 3) * KVBLK); SBAR();
        pv_d0(o, vb0 + SHM_V, pa0, pa1, pa2, pa3); partialSM<false>(pA0, pA1, m_reg, negm, alA);
        __syncthreads(); SWAIT(); SWRITE(1, SO);
        RESC(alA); __syncthreads();
    }
    SBAR(); qkt(pB0, pB1, K_lds + SHM_K, qr, negm, r32, hi);
    finishSM(pA0, pA1, alA, l_reg, pa0, pa1, pa2, pa3); SBAR();
    pv_d0(o, vb0, pa0, pa1, pa2, pa3); partialSM<false>(pB0, pB1, m_reg, negm, alB);
    __syncthreads(); RESC(alB);
    finishSM(pB0, pB1, alB, l_reg, pa0, pa1, pa2, pa3); SBAR();
    pv_d0(o, vb0 + SHM_V, pa0, pa1, pa2, pa3);
    if (hi == 0) li_l[r32] = l_reg; asm volatile("s_waitcnt lgkmcnt(0)" ::: "memory");
    float rli[16];
#pragma unroll
    for (int r = 0; r < 16; ++r) rli[r] = __builtin_amdgcn_rcpf(li_l[crow(r, hi)]);
    bf16* Ow = Ob + (long)(wid * QBLK) * LDO;
    __syncthreads();
    { bf16* stg = (bf16*)lds + wid * 4096;
#pragma unroll
      for (int r = 0; r < 16; ++r) { const int orow = crow(r, hi);
#pragma unroll
          for (int d0 = 0; d0 < 4; ++d0) stg[orow * 128 + d0 * 32 + r32] = (bf16)(cvt_pk_bf16(o[d0][r] * rli[r], 0.f) & 0xffffu); }
      asm volatile("s_waitcnt lgkmcnt(0)" ::: "memory");
#pragma unroll
      for (int i = 0; i < 8; ++i) { const int row = i * 4 + (lane >> 4), ch = lane & 15; const u32x4 v = *(const u32x4*)(stg + row * 128 + ch * 8); *(GAS u32x4*)(Ow + (long)row * LDO + ch * 8) = v; } }
    __syncthreads();
#undef SLOAD
#undef SWRITE
#undef SWAIT
#undef RESC
}
#undef KSWZ
#undef SBAR
}

#define XB_TMO      128
#define XB_XCNT(j)  (256  + 64 * (j))
#define XB_XSUB(j)  (1280 + 64 * (j))
#define XB_XGEN(j)  (2304 + 64 * (j))
#define XB_TOP      3328
#define XB_TOPGEN   3392
#define XCD_BAR_WORDS 3456
#define XB_SPIN_CAP (1u << 18)
__device__ __forceinline__ unsigned xb_ld(unsigned* p)              { return __hip_atomic_load(p, __ATOMIC_RELAXED, __HIP_MEMORY_SCOPE_AGENT); }
__device__ __forceinline__ unsigned xb_add(unsigned* p, unsigned v) { return __hip_atomic_fetch_add(p, v, __ATOMIC_RELAXED, __HIP_MEMORY_SCOPE_AGENT); }
__device__ __forceinline__ unsigned xb_xcc_id() { return (unsigned)__builtin_amdgcn_s_getreg((3 << 11) | 20) & 0xFu; }
#define XB_SPIN(cond, bar) do { unsigned _sp = 0; while (cond) { __builtin_amdgcn_s_sleep(1); \
    if ((++_sp & 255u) == 0u) { if (xb_ld(&(bar)[XB_TMO])) break; if (_sp > XB_SPIN_CAP) { atomicAdd(&(bar)[XB_TMO], 1u); break; } } } } while (0)
struct XcdBarrier { unsigned* bar; unsigned x; volatile LAS unsigned* st; };
__device__ __forceinline__ XcdBarrier xcd_barrier_post(unsigned* bar, volatile LAS unsigned* st) {
    XcdBarrier b; b.bar = bar; b.x = xb_xcc_id(); b.st = st;
    if (threadIdx.x == 0) (void)xb_add(&bar[XB_XCNT(b.x)], 1u);
    return b;
}
__device__ __forceinline__ void xcd_barrier_complete(unsigned* bar, unsigned x, unsigned& nloc, unsigned& nx) {
    const unsigned G = gridDim.x * gridDim.y * gridDim.z;
    unsigned sum, cnt, mine, sp = 0u;
    for (;;) {
        sum = 0u; cnt = 0u; mine = 0u;
#pragma unroll
        for (unsigned j = 0; j < 16; ++j) { const unsigned c = xb_ld(&bar[XB_XCNT(j)]); sum += c; cnt += (c > 0u) ? 1u : 0u; mine = (j == x) ? c : mine; }
        if (sum == G) break;
        __builtin_amdgcn_s_sleep(1);
        if ((++sp & 255u) == 0u) { if (xb_ld(&bar[XB_TMO])) break; if (sp > XB_SPIN_CAP) { atomicAdd(&bar[XB_TMO], 1u); break; } }
    }
    nloc = mine > 0u ? mine : 1u; nx = cnt > 0u ? cnt : 1u;
}
__device__ __forceinline__ void xcd_barrier(const XcdBarrier& b) {
    asm volatile("s_waitcnt vmcnt(0)" ::: "memory");
    __syncthreads();
    if (threadIdx.x == 0) {
        unsigned* bar = b.bar;
        __builtin_amdgcn_s_waitcnt(0);
        unsigned nloc = b.st[0], nx = b.st[1];
        if (nloc == 0u) { xcd_barrier_complete(bar, b.x, nloc, nx); b.st[0] = nloc; b.st[1] = nx; }
        const unsigned old = xb_add(&bar[XB_XSUB(b.x)], 1u);
        const unsigned gen = old / nloc;
        if (old + 1u == (gen + 1u) * nloc) {
            __builtin_amdgcn_fence(__ATOMIC_RELEASE, "agent");
            asm volatile("s_waitcnt vmcnt(0)" ::: "memory");
            const unsigned og = xb_add(&bar[XB_TOP], 1u);
            const unsigned tg = og / nx;
            if (og + 1u == (tg + 1u) * nx) xb_add(&bar[XB_TOPGEN], 1u);
            else XB_SPIN(xb_ld(&bar[XB_TOPGEN]) == tg, bar);
            __builtin_amdgcn_fence(__ATOMIC_ACQUIRE, "agent");
            xb_add(&bar[XB_XGEN(b.x)], 1u);
            asm volatile("s_waitcnt vmcnt(0)" ::: "memory");
        } else {
            XB_SPIN(xb_ld(&bar[XB_XGEN(b.x)]) == gen, bar);
            __builtin_amdgcn_fence(__ATOMIC_ACQUIRE, "agent");
            asm volatile("s_waitcnt vmcnt(0)" ::: "memory");
        }
    }
    __syncthreads();
}

constexpr int RING_BYTES = 131072, MISC_OFF = RING_BYTES + 320, LDS_BYTES = 147456;
constexpr int NPHASE = 23;
struct Args { const float* in[34]; float* out; unsigned char* ws; int ph_lo, ph_hi; };

struct Ctx {
    LAS unsigned char* lds; char* ldsg;
    int tid, lane, wave, G, vcu, gw, NGW;
    unsigned char* ws; unsigned char* ws0; const float* const* in; float* out;
};
#define WSP(T, off) ((T*)(C.ws + (off)))
#define RELAUNDER() do { long zz_ = 0; asm volatile("" : "+s"(zz_)); C.ws = C.ws0 + zz_; asm volatile("" ::: "memory"); } while (0)

__device__ __forceinline__ void tr_item(const float* W, int ldw, int k0, int c0, bf16* WT, int ldt, int r0, int permqk, LAS float* scr, int lane) {
    float tv[32];
#pragma unroll
    for (int i = 0; i < 32; ++i) tv[i] = W[(size_t)(k0 + 2 * i + (lane >> 5)) * ldw + c0 + (lane & 31)];
#pragma unroll
    for (int i = 0; i < 32; ++i) scr[(2 * i + (lane >> 5)) * 33 + (lane & 31)] = tv[i];
    LDS_WAIT(); asm volatile("" ::: "memory");
    const int c = lane & 7;
#pragma unroll
    for (int j = 0; j < 4; ++j) { const int n = (lane >> 3) + 8 * j; const LAS float* s = scr + (8 * c) * 33 + n;
        u32x4 o; o.x = cvt_pk_bf16(s[0 * 33], s[1 * 33]); o.y = cvt_pk_bf16(s[2 * 33], s[3 * 33]); o.z = cvt_pk_bf16(s[4 * 33], s[5 * 33]); o.w = cvt_pk_bf16(s[6 * 33], s[7 * 33]);
        const int dn = permqk ? (2 * (n & 15) + (n >> 4)) : n;
        *(GAS u32x4*)(WT + (size_t)(r0 + dn) * ldt + k0 + 8 * c) = o; }
    LDS_WAIT(); asm volatile("" ::: "memory");
}

__device__ __forceinline__ void tr_item8(const float* W, int ldw, int k0, int c0, unsigned char* WT, int ldt, int r0, float scale, LAS float* scr, int lane) {
    float tv[32];
#pragma unroll
    for (int i = 0; i < 32; ++i) tv[i] = W[(size_t)(k0 + 2 * i + (lane >> 5)) * ldw + c0 + (lane & 31)];
#pragma unroll
    for (int i = 0; i < 32; ++i) scr[(2 * i + (lane >> 5)) * 33 + (lane & 31)] = tv[i] * scale;
    LDS_WAIT(); asm volatile("" ::: "memory");
    const int c = lane & 7;
#pragma unroll
    for (int j = 0; j < 4; ++j) { const int n = (lane >> 3) + 8 * j; const LAS float* s = scr + (8 * c) * 33 + n;
        u32x2 o; o.x = cvt4_fp8(s[0 * 33], s[1 * 33], s[2 * 33], s[3 * 33]); o.y = cvt4_fp8(s[4 * 33], s[5 * 33], s[6 * 33], s[7 * 33]);
        *(GAS u32x2*)(WT + (size_t)(r0 + n) * ldt + k0 + 8 * c) = o; }
    LDS_WAIT(); asm volatile("" ::: "memory");
}

template <bool FP8 = false> __device__ __forceinline__ void row_norm_mod(f32x4 (&v)[4], const float* w, const float* sc, const float* sh, bf16* orow, int lane) {
    float ss = 0.f;
#pragma unroll
    for (int j = 0; j < 4; ++j) ss += (v[j].x * v[j].x + v[j].y * v[j].y) + (v[j].z * v[j].z + v[j].w * v[j].w);
    const float rstd = rsqrtf(wave_sum(ss) * (1.f / 1024.f) + EPS);
#pragma unroll
    for (int j = 0; j < 4; ++j) { const int c4 = lane + 64 * j; const f32x4 wv = ((const f32x4*)w)[c4], scv = ((const f32x4*)sc)[c4], shv = ((const f32x4*)sh)[c4];
        v[j] = v[j] * rstd * wv * (1.f + scv) + shv;
        if constexpr (FP8) { ((GAS unsigned*)orow)[c4] = cvt4_fp8_sat(v[j].x * MOE_AS, v[j].y * MOE_AS, v[j].z * MOE_AS, v[j].w * MOE_AS); }
        else { u32x2 o; o.x = cvt_pk_bf16(v[j].x, v[j].y); o.y = cvt_pk_bf16(v[j].z, v[j].w); ((GAS u32x2*)orow)[c4] = o; } }
}
__device__ __forceinline__ void load_row_f32(f32x4 (&v)[4], const float* row, int lane) {
#pragma unroll
    for (int j = 0; j < 4; ++j) v[j] = ((const GAS f32x4*)row)[lane + 64 * j];
}
__device__ __forceinline__ void load_row_bf16(f32x4 (&v)[4], const bf16* row, int lane) {
#pragma unroll
    for (int j = 0; j < 4; ++j) { const u32x2 w = ((const GAS u32x2*)row)[lane + 64 * j]; v[j] = (f32x4){bflo(w.x), bfhi(w.x), bflo(w.y), bfhi(w.y)}; }
}
__device__ __forceinline__ void store_row_f32(const f32x4 (&v)[4], float* row, int lane) {
#pragma unroll
    for (int j = 0; j < 4; ++j) ((GAS f32x4*)row)[lane + 64 * j] = v[j];
}
__device__ __forceinline__ void row_post(f32x4 (&v)[4], const f32x4 (&base)[4], const float* w, const float* g, int lane) {
    float ss = 0.f;
#pragma unroll
    for (int j = 0; j < 4; ++j) ss += (v[j].x * v[j].x + v[j].y * v[j].y) + (v[j].z * v[j].z + v[j].w * v[j].w);
    const float rstd = rsqrtf(wave_sum(ss) * (1.f / 1024.f) + EPS);
#pragma unroll
    for (int j = 0; j < 4; ++j) { const int c4 = lane + 64 * j; const f32x4 wv = ((const f32x4*)w)[c4], gv = ((const f32x4*)g)[c4]; v[j] = base[j] + gv * (v[j] * rstd * wv); }
}

#define ROWMAP_DECL() const int WPB_ = C.NGW / NB, rb_ = C.gw / WPB_, wi_ = C.gw % WPB_
#define ROW_S(k) (wi_ + WPB_ * (k))
struct Cplx { float r, i; };
__device__ __forceinline__ Cplx cmul(Cplx a, Cplx b) { return Cplx{a.r * b.r - a.i * b.i, a.r * b.i + a.i * b.r}; }
__device__ __forceinline__ Cplx cpow(Cplx a, int e) { Cplx r{1.f, 0.f};
#pragma unroll
    for (int bit = 0; bit < 7; ++bit) { if (e & (1 << bit)) r = cmul(r, a); a = cmul(a, a); }
    return r; }
__device__ __forceinline__ void s5_disc(const float* a_re, const float* a_im, const float* log_dt, int dgp  , Cplx& lam, Cplx& coef) {
    const float ar = a_re[dgp], ai = a_im[dgp], dt = __expf(log_dt[dgp >> 6]);
    const float mag = __expf(ar * dt); float rev = ai * dt * 0.15915494309189535f; rev -= rintf(rev);
    lam.r = mag * cosrev(rev); lam.i = mag * sinrev(rev);
    const float nr = lam.r - 1.f, ni = lam.i, den = ar * ar + ai * ai;
    coef.r = (nr * ar + ni * ai) / den; coef.i = (ni * ar - nr * ai) / den;
}

__device__ __forceinline__ void ph_pre_a(Ctx& C) {
    const float* c_in = C.in[1]; const float* cctx = C.in[3]; const float* ada_w = C.in[4]; const float* ada_b = C.in[5];
    if ((int)blockIdx.x < 192) {
        LAS float* sl = (LAS float*)C.lds;
        LAS float* red = (LAS float*)(C.lds + 17 * 1024 * 4);
        for (int i = C.tid; i < 17 * 1024; i += 512) { const float x = (i < 16384) ? c_in[i] : cctx[i - 16384]; sl[i] = fsilu(x); }
        __syncthreads();
        for (int it = blockIdx.x; it < 192; it += C.G) {
            const int l = it / 96, cb = it % 96, col = cb * 64 + (C.tid & 63), ks = C.tid >> 6;
            float acc[17];
#pragma unroll
            for (int b = 0; b < 17; ++b) acc[b] = 0.f;
            const float* wp = ada_w + (size_t)l * 1024 * 6144 + col;
#pragma unroll 8
            for (int k = ks * 128; k < ks * 128 + 128; ++k) { const float w = wp[(size_t)k * 6144];
#pragma unroll
                for (int b = 0; b < 17; ++b) acc[b] += sl[b * 1024 + k] * w; }
#pragma unroll
            for (int b = 0; b < 17; ++b) red[(ks * 17 + b) * 64 + (C.tid & 63)] = acc[b];
            __syncthreads();
            for (int i = C.tid; i < 17 * 64; i += 512) { const int b = i >> 6, cc = i & 63; float s = ada_b[l * 6144 + cb * 64 + cc];
#pragma unroll
                for (int k8 = 0; k8 < 8; ++k8) s += red[(k8 * 17 + b) * 64 + cc];
                WSP(float, WS_MODS)[((size_t)l * 17 + b) * 6144 + cb * 64 + cc] = s; }
            __syncthreads();
        }
    }
    __syncthreads();
    {
        LAS float* scr = (LAS float*)(C.lds + C.wave * 16384);
        constexpr int I_WIN = 16 * 56, I_WOUT = 16 * 32, I_GLU = 4 * 8, I_L = I_WIN + I_WOUT + I_GLU, I_G = 16 * 88, I_D = 44 * 32, NIT = 2 * I_L + 2 * I_G + I_D;
        for (int it = C.gw; it < NIT; it += C.NGW) {
            int r = it;
            if (r < 2 * I_L) { const int l = r / I_L; r %= I_L;
                if (r < I_WIN) { const int kb = r / 56, nb = r % 56; const int c0 = nb < 48 ? nb * 32 : 1792 + (nb - 48) * 32;
                    tr_item(C.in[10] + (size_t)l * 1024 * 2048, 2048, kb * 64, c0, WSP(bf16, WS_WIN) + (size_t)l * NWIN * 1024, 1024, nb * 32, nb < 32, scr, C.lane); continue; }
                r -= I_WIN;
                if (r < I_WOUT) { const int kb = r / 32, nb = r % 32; tr_item(C.in[11] + (size_t)l * 1024 * 1024, 1024, kb * 64, nb * 32, WSP(bf16, WS_WOUT) + (size_t)l * 1024 * 1024, 1024, nb * 32, 0, scr, C.lane); continue; }
                r -= I_WOUT;
                { const int kb = r / 8, nb = r % 8; tr_item(C.in[26] + (size_t)l * 65536, 256, kb * 64, nb * 32, WSP(bf16, WS_GLU) + (size_t)l * 65536, 256, nb * 32, 0, scr, C.lane); continue; }
            }
            r -= 2 * I_L;
            if (r < 2 * I_G) { const int up = r / I_G; r %= I_G; const int kb = r / 88, nb = r % 88;
                tr_item(C.in[27 + up], FD, kb * 64, nb * 32, WSP(bf16, WS_WGU), 1024, (nb >> 2) * 256 + up * 128 + (nb & 3) * 32, 0, scr, C.lane); continue; }
            r -= 2 * I_G;
            { const int kb = r / 32, nb = r % 32; tr_item(C.in[29], 1024, kb * 64, nb * 32, WSP(bf16, WS_WD), FD, nb * 32, 0, scr, C.lane); }
        }
    }
    const int gt = C.vcu * 512 + C.tid, NGT = C.G * 512;
    for (int it = gt; it < 2 * 256 * 512; it += NGT) {
        const int l = it >> 17, c = (it >> 9) & 255, n = it & 511, nn = n & 255, sn = n >> 8; const float* fw = C.in[17] + (size_t)l * 65536 + (size_t)(c & ~63) * 256 + nn; float s = 0.f;
        for (int j = 0; j < 64; ++j) { const float rev = (float)(((c & 63) * j) & 63) * (1.f / 64.f); s += (sn ? sinrev(rev) : cosrev(rev)) * fw[(size_t)j * 256]; }
        WSP(float, WS_WCWS)[it] = s * 0.125f;
    }
    for (int it = gt; it < 2048 * 512; it += NGT) { const int k = it >> 9, t0 = (it & 511) * 8; float v[8];
#pragma unroll
        for (int e = 0; e < 8; ++e) { const int tp = t0 + e, t = tp & 2047; const float rev = (float)((k * t) & 2047) * (1.f / 2048.f); v[e] = (tp < 2048 ? cosrev(rev) : -sinrev(rev)) * 0.02209708691207961f; }
        u32x4 o; o.x = cvt_pk_bf16(v[0], v[1]); o.y = cvt_pk_bf16(v[2], v[3]); o.z = cvt_pk_bf16(v[4], v[5]); o.w = cvt_pk_bf16(v[6], v[7]);
        *(GAS u32x4*)(WSP(bf16, WS_DFTL) + (size_t)k * 4096 + t0) = o; }
    for (int it = gt; it < 256 * 64; it += NGT) { const int k = it >> 6, t0 = (it & 63) * 8; float v[8];
#pragma unroll
        for (int e = 0; e < 8; ++e) { const int tp = t0 + e, t = tp & 255; const float rev = (float)((k * t) & 255) * (1.f / 256.f); v[e] = (tp < 256 ? cosrev(rev) : -sinrev(rev)) * 0.0625f; }
        u32x4 o; o.x = cvt_pk_bf16(v[0], v[1]); o.y = cvt_pk_bf16(v[2], v[3]); o.z = cvt_pk_bf16(v[4], v[5]); o.w = cvt_pk_bf16(v[6], v[7]);
        *(GAS u32x4*)(WSP(bf16, WS_DFTC) + (size_t)k * 512 + t0) = o; }
    for (int it = gt; it < 2 * 2048; it += NGT) { const int l = it >> 11, dgp = it & 2047; Cplx lam, coef; s5_disc(C.in[18] + l * 2048, C.in[19] + l * 2048, C.in[20] + l * 32, dgp, lam, coef);
        f32x2* pw = WSP(f32x2, WS_S5POW) + (size_t)it * 66; Cplx a{1.f, 0.f};
        f32x2* pt = WSP(f32x2, WS_S5POWT) + ((size_t)(l * 32 + (dgp >> 6)) * 65) * 64 + (dgp & 63);
        for (int e = 0; e <= 64; ++e) { pw[e] = (f32x2){a.r, a.i}; pt[(size_t)e * 64] = (f32x2){a.r, a.i}; a = cmul(a, lam); }
        pw[65] = (f32x2){coef.r, coef.i}; }
    for (int it = gt; it < 1024; it += NGT) { const int pos = it >> 4, i = it & 15; const float inv = exp2f(-(float)i * (13.287712379549449f / 16.f)); float rev = (float)pos * inv * 0.15915494309189535f; rev -= floorf(rev);
        WSP(float, WS_ROPE)[2 * it] = cosrev(rev); WSP(float, WS_ROPE)[2 * it + 1] = sinrev(rev); }
}

__device__ __forceinline__ void s5_build(Ctx& C, int l, int mask = 7) {
    const float* a_re = C.in[18] + l * 2048; const float* a_im = C.in[19] + l * 2048; const float* log_dt = C.in[20] + l * 32;
    const float* b_re = C.in[21] + (size_t)l * 32768; const float* b_im = C.in[22] + (size_t)l * 32768;
    const float* c_re = C.in[23] + (size_t)l * 32768; const float* c_im = C.in[24] + (size_t)l * 32768;
    bf16* KIN = WSP(bf16, WS_KIN); bf16* KTOT = WSP(bf16, WS_KTOT);
    const int gt = C.vcu * 512 + C.tid, NGT = C.G * 512;
    if (mask & 1) for (int it = gt; it < 16 * 256 * CHT; it += NGT) {
        const int g = it >> 12, n = (it >> 4) & 255, sx = it & 15, dir = n >> 7, reim = (n >> 6) & 1, p = n & 63, dgp = (dir * 16 + g) * 64 + p;
        const f32x2* pw = WSP(f32x2, WS_S5POW) + ((size_t)l * 2048 + dgp) * 66; const f32x2 pe = pw[dir ? sx : CHT - 1 - sx], pc = pw[65]; const Cplx P = cmul(Cplx{pe.x, pe.y}, Cplx{pc.x, pc.y});
        const float* br = b_re + (size_t)dgp * 16; const float* bi = b_im + (size_t)dgp * 16; float v[16];
#pragma unroll
        for (int ch = 0; ch < 16; ++ch) { const Cplx x = cmul(P, Cplx{br[ch], bi[ch]}); v[ch] = reim ? x.i : x.r; }
        u32x4 o0, o1; o0.x = cvt_pk_bf16(v[0], v[1]); o0.y = cvt_pk_bf16(v[2], v[3]); o0.z = cvt_pk_bf16(v[4], v[5]); o0.w = cvt_pk_bf16(v[6], v[7]);
        o1.x = cvt_pk_bf16(v[8], v[9]); o1.y = cvt_pk_bf16(v[10], v[11]); o1.z = cvt_pk_bf16(v[12], v[13]); o1.w = cvt_pk_bf16(v[14], v[15]);
        GAS u32x4* dst = (GAS u32x4*)(KIN + ((size_t)g * 256 + n) * S5K1 + sx * 16); dst[0] = o0; dst[1] = o1;
    }
    if (mask & 2) for (int it = gt; it < 16 * 256 * 256; it += NGT) {
        const int g = it >> 16, n2 = (it >> 8) & 255, n = it & 255, t = n2 >> 4, ch = n2 & 15, dir = n >> 7, reim = (n >> 6) & 1, p = n & 63;
        const f32x2 pe = WSP(f32x2, WS_S5POWT)[((size_t)(l * 32 + dir * 16 + g) * 65 + (dir ? CHT - t : t + 1)) * 64 + p];
        const size_t ci = ((size_t)(dir * 16 + g) * 16 + ch) * 64 + p; const Cplx W = cmul(Cplx{c_re[ci], c_im[ci]}, Cplx{pe.x, pe.y});
        KTOT[((size_t)g * 256 + n2) * S5K2 + S5K1 + n] = (bf16)(cvt_pk_bf16(reim ? -W.i : W.r, 0.f) & 0xffffu);
    }
    if (mask & 4) {
        constexpr int TB = 4;
        LAS float* LP = (LAS float*)C.lds;
        LAS float* KT = LP + TB * 256;
        LAS float* CR = KT + TB * 512;
        LAS float* CI = CR + 2048; LAS float* BR = CI + 2048; LAS float* BI = BR + 2048;
        constexpr int nb = 16 * CHT / TB;
        int gl = -1;
        for (int bt = C.vcu; bt < nb; bt += C.G) {
            const int g = (bt * TB) / CHT, tau0 = (bt * TB) % CHT;
            __syncthreads();
            if (g != gl) { for (int i = C.tid; i < 2048; i += 512) { const int dir = i >> 10, r = i & 1023; const size_t o = (size_t)(dir * 16 + g) * 1024 + r; CR[i] = c_re[o]; CI[i] = c_im[o]; BR[i] = b_re[o]; BI[i] = b_im[o]; } gl = g; }
            { const int tb = C.tid >> 7, dir = (C.tid >> 6) & 1, p = C.tid & 63; const f32x2* pw = WSP(f32x2, WS_S5POW) + ((size_t)l * 2048 + (dir * 16 + g) * 64 + p) * 66; const f32x2 pe = pw[tau0 + tb], pc = pw[65];
              const Cplx P = cmul(Cplx{pe.x, pe.y}, Cplx{pc.x, pc.y}); LP[2 * C.tid] = P.r; LP[2 * C.tid + 1] = P.i; }
            __syncthreads();
            { const int dir = C.tid >> 8, ch = (C.tid >> 4) & 15, cp = C.tid & 15; float sacc[TB];
#pragma unroll
              for (int tb = 0; tb < TB; ++tb) sacc[tb] = 0.f;
#pragma unroll 4
              for (int p = 0; p < 64; ++p) { const int ci = dir * 1024 + ch * 64 + p, bi_ = dir * 1024 + p * 16 + cp; const Cplx cb = cmul(Cplx{CR[ci], CI[ci]}, Cplx{BR[bi_], BI[bi_]});
#pragma unroll
                  for (int tb = 0; tb < TB; ++tb) { const int li = 2 * (tb * 128 + dir * 64 + p); sacc[tb] += cb.r * LP[li] - cb.i * LP[li + 1]; } }
#pragma unroll
              for (int tb = 0; tb < TB; ++tb) KT[tb * 512 + C.tid] = sacc[tb]; }
            __syncthreads();
#pragma unroll
            for (int tb = 0; tb < TB; ++tb) { const int tau = tau0 + tb, nblk = CHT - tau; const LAS float* kt = KT + tb * 512;
                for (int w = C.tid; w < 2 * nblk * 32; w += 512) {
                    const int dir = w >= nblk * 32, r = dir ? w - nblk * 32 : w, blk = r >> 5, ch = (r >> 1) & 15, half = r & 1;
                    if (tau == 0 && dir == 1) continue;
                    const int t = dir ? blk : blk + tau, sx = dir ? blk + tau : blk; float v[8];
#pragma unroll
                    for (int e = 0; e < 8; ++e) { v[e] = kt[dir * 256 + ch * 16 + half * 8 + e]; if (tau == 0) v[e] += kt[256 + ch * 16 + half * 8 + e]; }
                    u32x4 o; o.x = cvt_pk_bf16(v[0], v[1]); o.y = cvt_pk_bf16(v[2], v[3]); o.z = cvt_pk_bf16(v[4], v[5]); o.w = cvt_pk_bf16(v[6], v[7]);
                    *(GAS u32x4*)(KTOT + ((size_t)g * 256 + t * 16 + ch) * S5K2 + sx * 16 + half * 8) = o;
                } }
        }
        __syncthreads();
    }
}

__device__ __forceinline__ const float* xrow_in(Ctx& C, int r) { const int b = r / SA, s = r % SA; return s < CT ? C.in[2] + ((size_t)b * CT + s) * 1024 : C.in[0] + ((size_t)b * SQ + (s - CT)) * 1024; }
__device__ __forceinline__ float* xrow_cur(Ctx& C, int r) { const int b = r / SA, s = r % SA; return s < CT ? WSP(float, WS_X1C) + ((size_t)b * CT + s) * 1024 : C.out + ((size_t)b * SQ + (s - CT)) * 1024; }
__device__ __forceinline__ const float* modp(Ctx& C, int l, int r, int chunk) { const int b = r / SA, s = r % SA; return WSP(float, WS_MODS) + ((size_t)l * 17 + (s < CT ? 16 : b)) * 6144 + chunk * 1024; }

__device__ __forceinline__ void ph_pre_b(Ctx& C) {
    const int gt = C.vcu * 512 + C.tid, NGT = C.G * 512;
    for (int it = C.vcu; it < 2 * 128; it += C.G) {
        const int l = it >> 7, kc = it & 127, n = C.tid; const float* wi = C.in[10] + (size_t)l * 1024 * 2048 + (size_t)(kc * 8) * 2048 + 1536; const float* wc = WSP(float, WS_WCWS) + (size_t)l * 131072 + n;
        LAS float* wl = (LAS float*)C.lds;
        __syncthreads();
        for (int i = C.tid; i < 2048; i += 512) wl[i] = wi[(size_t)(i >> 8) * 2048 + (i & 255)];
        __syncthreads();
        float acc[8];
#pragma unroll
        for (int e = 0; e < 8; ++e) acc[e] = 0.f;
#pragma unroll 8
        for (int j = 0; j < 256; ++j) { const float w = wc[(size_t)j * 512];
#pragma unroll
            for (int e = 0; e < 8; ++e) acc[e] += wl[e * 256 + j] * w; }
        u32x4 o; o.x = cvt_pk_bf16(acc[0], acc[1]); o.y = cvt_pk_bf16(acc[2], acc[3]); o.z = cvt_pk_bf16(acc[4], acc[5]); o.w = cvt_pk_bf16(acc[6], acc[7]);
        *(GAS u32x4*)(WSP(bf16, WS_WIN) + ((size_t)l * NWIN + 1792 + n) * 1024 + kc * 8) = o;
    }
    { constexpr int NR = 6; ROWMAP_DECL();
      for (int k0 = 0; ROW_S(k0) < SA; k0 += NR) { f32x4 v[NR][4];
#pragma unroll
        for (int q = 0; q < NR; ++q) { const int sx = ROW_S(k0 + q), r = rb_ * SA + sx; if (sx < SA) load_row_f32(v[q], xrow_in(C, r), C.lane); }
#pragma unroll
        for (int q = 0; q < NR; ++q) { const int sx = ROW_S(k0 + q), r = rb_ * SA + sx; if (sx < SA) row_norm_mod(v[q], C.in[6], modp(C, 0, r, 1), modp(C, 0, r, 0), WSP(bf16, WS_HN) + (size_t)r * 1024, C.lane); } } }
    s5_build(C, 0);
}

__device__ __forceinline__ void ph_win(Ctx& C, int l) {
    {
        pg8::Gemm g{WSP(bf16, WS_HN), WSP(bf16, WS_WIN) + (size_t)l * NWIN * 1024}; typedef pg8::Shape<1024, 1024, 1024> Sh;
        EpiIn E{C.ws};
        if (l == 0) { ListOrder<Dec2D> S{144 * 7, C.G, (int)blockIdx.x, Dec2D{144, 7, 0, 0}}; pg8::gemm_phase<Sh>(C.lds, g, S, E); }
        else { ListOrder<DecWin1> S{976, C.G, (int)blockIdx.x, DecWin1{}}; pg8::gemm_phase<Sh>(C.lds, g, S, E); }
    }
    RELAUNDER();
    {
        pg8::Gemm g{WSP(bf16, WS_WIN) + ((size_t)l * NWIN + 1792) * 1024, WSP(bf16, WS_HN)}; typedef pg8::Shape<1024, 1024, 1024> Sh;
        const int nN = l == 0 ? 144 : 128;
        ListOrder<Dec2D> S{2 * nN, C.G, (int)blockIdx.x, Dec2D{2, nN, 0, l == 0 ? 0 : 1}};
        EpiFT E{C.ws};
        pg8::gemm_phase<Sh>(C.lds, g, S, E);
    }
}

__device__ __forceinline__ void attn_dispatch(Ctx& C, int u) {
    const bf16* Q = WSP(bf16, WS_Q); const bf16* K = WSP(bf16, WS_K); const bf16* V = WSP(bf16, WS_V); bf16* AO = WSP(bf16, WS_AO);
    int b, h, map, qrow, seq;
    if (u < 1024) { const int qb = u & 7; map = (u >> 3) & 1; h = (u >> 4) & 3; b = u >> 6; qrow = b * SA + CT + qb * 256; seq = SA; }
    else { const int uc = u - 1024; map = uc & 1; h = (uc >> 1) & 3; b = uc >> 3; qrow = b * SA; seq = CT; }
    const int hm = (h * 2 + map) * 64;
    att::attn_unit(Q + (size_t)qrow * 512 + hm, K + (size_t)(b * SA) * 512 + hm, V + (size_t)(b * SA) * 512 + h * 128, AO + (size_t)qrow * 1024 + (h * 2 + map) * 128, seq, C.ldsg);
}
__device__ __forceinline__ void ph_mix(Ctx& C, int l) {
    const bool bal = (C.G == 256); const int cb = C.vcu - 128;
    int gc = C.G, gi = C.vcu;
    if (bal) { gc = 128; gi = cb >= 0 ? cb : (1 << 28); }
    if (bal) {
        if (cb < 0) { for (int j = 0; j < 5; ++j) attn_dispatch(C, C.vcu + 128 * j); }
        else { for (int j = 0; j < 3; ++j) attn_dispatch(C, 640 + cb + 128 * j); if (l == 0) attn_dispatch(C, 1024 + cb); }
    } else {
        const int NU = 1024 + (l == 0 ? 128 : 0);
        for (int u = C.vcu; u < NU; u += C.G) attn_dispatch(C, u);
    }
    RELAUNDER();
    {
        pg8::Gemm g{WSP(bf16, WS_DFTL), WSP(bf16, WS_FT2)}; typedef pg8::Shape<4096, 4096, 4096> Sh;
        ListOrder<Dec2D> S{8 * 16, gc, gi, Dec2D{8, 16, 0, 0}};
        EpiDft E{C.ws, CT};
        pg8::gemm_phase<Sh>(C.lds, g, S, E);
    }
    RELAUNDER();
    if (l == 0) {
        pg8::Gemm g{WSP(bf16, WS_DFTC), WSP(bf16, WS_FTC)}; typedef pg8::Shape<512, 512, 512> Sh;
        ListOrder<Dec2D> S{16, gc, gi, Dec2D{1, 16, 0, 0}};
        EpiDft E{C.ws, 0};
        pg8::gemm_phase<Sh>(C.lds, g, S, E);
    }
    RELAUNDER();
    {
        pg8::Gemm g{WSP(bf16, WS_UA), WSP(bf16, WS_KIN)}; typedef pg8::Shape<S5K2, S5K1, S5K1, (long)S5ROWS * S5K2, 256L * S5K1> Sh;
        ListOrder<DecBatch> S{16 * 9, gc, gi, DecBatch{9, 1}};
        EpiF32z<WS_HLOC, 256, (long)S5ROWS * 256> E{C.ws};
        pg8::gemm_phase<Sh>(C.lds, g, S, E);
    }
}

__device__ __forceinline__ void ph_carry(Ctx& C, int l) {
    const int NCW = (C.G > 64) ? 64 : 0;
    const int gt = C.vcu * 512 + C.tid, NGT = (NCW ? NCW : C.G) * 512;
    if (C.vcu < NCW || NCW == 0) for (int it = gt; it < 16 * 16 * 2 * 64; it += NGT) {
        const int g = it >> 11, b = (it >> 7) & 15, dir = (it >> 6) & 1, p = it & 63;
        const f32x2 pT = WSP(f32x2, WS_S5POW)[((size_t)l * 2048 + (dir * 16 + g) * 64 + p) * 66 + CHT]; const Cplx LT{pT.x, pT.y};
        const float* hl = WSP(float, WS_HLOC) + ((size_t)g * S5ROWS + b * NCH) * 256 + dir * 128 + p; bf16* ua = WSP(bf16, WS_UA) + ((size_t)g * S5ROWS + b * NCH) * S5K2 + S5K1 + dir * 128 + p;
        Cplx h{0.f, 0.f};
        constexpr int CB = 36, NCC = CT / CHT;
        for (int i0 = 0; i0 < NCH; i0 += CB) { float xr[CB], xi[CB];
#pragma unroll
            for (int j = 0; j < CB; ++j) { const int i = i0 + j, c = dir ? (i < NCC ? NCC - 1 - i : NCH + NCC - 1 - i) : i; xr[j] = hl[(size_t)c * 256]; xi[j] = hl[(size_t)c * 256 + 64]; }
#pragma unroll
            for (int j = 0; j < CB; ++j) { const int i = i0 + j, c = dir ? (i < NCC ? NCC - 1 - i : NCH + NCC - 1 - i) : i;
                ua[(size_t)c * S5K2] = (bf16)(cvt_pk_bf16(h.r, 0.f) & 0xffffu); ua[(size_t)c * S5K2 + 64] = (bf16)(cvt_pk_bf16(h.i, 0.f) & 0xffffu); h = cmul(LT, h); h.r += xr[j]; h.i += xi[j]; }
        }
    }
    {
        const float li = l == 0 ? 0.2f : 0.35550906759559083f; float d1 = C.in[12][l * 64 + C.lane] * C.in[13][l * 64 + C.lane], d2 = C.in[14][l * 64 + C.lane] * C.in[15][l * 64 + C.lane];
        const float lamv = __expf(wave_sum(d1)) - __expf(wave_sum(d2)) + li; const float* sub = C.in[16] + l * 128; const bf16* AO = WSP(bf16, WS_AO); bf16* CAT = WSP(bf16, WS_CAT);
        const int hh = C.lane >> 4, d8 = (C.lane & 15) * 8; f32x4 s0 = *(const f32x4*)(sub + d8), s1 = *(const f32x4*)(sub + d8 + 4);
        constexpr int NR = 6; const int fgw = C.gw - NCW * 8, FNGW = C.NGW - NCW * 8;
        if (fgw >= 0) for (int r0 = fgw; r0 < MR; r0 += NR * FNGW) { u32x4 aa[NR], bb[NR]; bool ok[NR];
#pragma unroll
            for (int q = 0; q < NR; ++q) { const int r = r0 + q * FNGW; ok[q] = r < MR && !(l == 1 && (r % SA) < CT);
                if (ok[q]) { aa[q] = *(const GAS u32x4*)(AO + (size_t)r * 1024 + hh * 256 + d8); bb[q] = *(const GAS u32x4*)(AO + (size_t)r * 1024 + hh * 256 + 128 + d8); } }
#pragma unroll
            for (int q = 0; q < NR; ++q) { if (!ok[q]) continue; const int r = r0 + q * FNGW; const u32x4 a = aa[q], bq = bb[q]; float v[8];
            v[0] = bflo(a.x) - lamv * bflo(bq.x); v[1] = bfhi(a.x) - lamv * bfhi(bq.x); v[2] = bflo(a.y) - lamv * bflo(bq.y); v[3] = bfhi(a.y) - lamv * bfhi(bq.y);
            v[4] = bflo(a.z) - lamv * bflo(bq.z); v[5] = bfhi(a.z) - lamv * bfhi(bq.z); v[6] = bflo(a.w) - lamv * bflo(bq.w); v[7] = bfhi(a.w) - lamv * bfhi(bq.w);
            float ss = 0.f;
#pragma unroll
            for (int e = 0; e < 8; ++e) ss += v[e] * v[e];
#pragma unroll
            for (int o = 1; o < 16; o <<= 1) ss += __shfl_xor(ss, o);
            const float sc = rsqrtf(ss * (1.f / 128.f) + EPS) * (1.f - li);
            u32x4 o; o.x = cvt_pk_bf16(v[0] * sc * s0[0], v[1] * sc * s0[1]); o.y = cvt_pk_bf16(v[2] * sc * s0[2], v[3] * sc * s0[3]); o.z = cvt_pk_bf16(v[4] * sc * s1[0], v[5] * sc * s1[1]); o.w = cvt_pk_bf16(v[6] * sc * s1[2], v[7] * sc * s1[3]);
            *(GAS u32x4*)(CAT + (size_t)r * 1024 + hh * 128 + d8) = o; } }
    }
}

__device__ __forceinline__ void ph_s5g2(Ctx& C, int l) {
    pg8::Gemm g{WSP(bf16, WS_UA), WSP(bf16, WS_KTOT)}; typedef pg8::Shape<S5K2, S5K2, S5K2, (long)S5ROWS * S5K2, 256L * S5K2> Sh;
    ListOrder<DecBatch> S{16 * 9, C.G, (int)blockIdx.x, DecBatch{9, 1}};
    EpiS5 E{C.ws, C.in[25] + l * 256, l == 1};
    pg8::gemm_phase<Sh>(C.lds, g, S, E);
}
__device__ __forceinline__ void ph_glu(Ctx& C, int l) {
    pg8::Gemm g{WSP(bf16, WS_YY), WSP(bf16, WS_GLU) + (size_t)l * 65536}; typedef pg8::Shape<256, 256, 256> Sh;
    const int nM = l == 0 ? 144 : 128;
    ListOrder<Dec2D> S{nM, C.G, (int)blockIdx.x, Dec2D{nM, 1, l == 0 ? 0 : 1, 0}};
    EpiGlu E{C.ws};
    pg8::gemm_phase<Sh>(C.lds, g, S, E);
}
__device__ __forceinline__ void ph_wout(Ctx& C, int l) {
    pg8::Gemm g{WSP(bf16, WS_CAT), WSP(bf16, WS_WOUT) + (size_t)l * 1024 * 1024}; typedef pg8::Shape<1024, 1024, 1024> Sh;
    { ListOrder<Dec2D> S{128 * 4, C.G, (int)blockIdx.x, Dec2D{128, 4, 1, 0}};
      EpiPlain<WS_HN, 1024> E{C.ws};
      pg8::gemm_phase<Sh>(C.lds, g, S, E); }
    if (l == 0) {
        RELAUNDER();
        pg8::Gemm g2{WSP(bf16, WS_CAT), WSP(bf16, WS_WOUT)}; typedef pg8::Shape<1024, 1024, 512, 512, 512> Sh2;
        ListOrder<DecCtxK> S{128, C.G, (int)blockIdx.x, DecCtxK{}};
        EpiCtxPart E{C.ws};
        pg8::gemm_phase<Sh2>(C.lds, g2, S, E);
    }
}

template <int l> __device__ __forceinline__ void ph_norm2(Ctx& C) {
    unsigned char* H2 = C.ws + (l == 0 ? WS_H2_L0 : WS_H2_L1); const bf16* MIX = WSP(bf16, WS_HN);
    LAS int* lcnt = (LAS int*)C.lds;
    if (l == 1) { if (C.tid < NEXP) lcnt[C.tid] = 0; __syncthreads(); }
    f32x4 rtr[4][4][2];
    if (l == 1) {
#pragma unroll
        for (int j = 0; j < 4; ++j)
#pragma unroll
            for (int q = 0; q < 4; ++q) { const float* rp = C.in[30] + (size_t)(4 * (C.lane + 64 * j) + q) * 8; rtr[j][q][0] = *(const f32x4*)rp; rtr[j][q][1] = *(const f32x4*)(rp + 4); }
    }
    constexpr int NR = l == 1 ? 2 : 3;
    ROWMAP_DECL();
    for (int k0 = 0; ROW_S(k0) < SA; k0 += NR) {
      f32x4 vv[NR][4], xx[NR][4]; bool ok[NR];
#pragma unroll
      for (int q = 0; q < NR; ++q) { const int sx = ROW_S(k0 + q), r = rb_ * SA + sx; ok[q] = sx < SA && !(l == 1 && sx < CT);
          if (ok[q]) { if (l == 0 && sx < CT) { f32x4 t2[4]; const bf16* cp = WSP(bf16, WS_CPART) + (size_t)(rb_ * CT + sx) * 1024; load_row_bf16(vv[q], cp, C.lane); load_row_bf16(t2, cp + (size_t)4096 * 1024, C.lane);
#pragma unroll
                  for (int j = 0; j < 4; ++j) vv[q][j] += t2[j]; }
              else load_row_bf16(vv[q], MIX + (size_t)r * 1024, C.lane);
              load_row_f32(xx[q], l == 0 ? xrow_in(C, r) : (const float*)xrow_cur(C, r), C.lane); } }
#pragma unroll
      for (int q = 0; q < NR; ++q) {
        if (!ok[q]) continue;
        const int r = rb_ * SA + ROW_S(k0 + q); f32x4 (&v)[4] = vv[q]; f32x4 (&x)[4] = xx[q];
        row_post(v, x, C.in[7] + l * 1024, modp(C, l, r, 2), C.lane);
        store_row_f32(v, xrow_cur(C, r), C.lane);
        if (l == 0) row_norm_mod<false>(v, C.in[8] + l * 1024, modp(C, l, r, 4), modp(C, l, r, 3), (bf16*)H2 + (size_t)r * 1024, C.lane);
        else row_norm_mod<true>(v, C.in[8] + l * 1024, modp(C, l, r, 4), modp(C, l, r, 3), (bf16*)(H2 + (size_t)r * 1024), C.lane);
        if (l == 1) {
            float lg[8];
#pragma unroll
            for (int e = 0; e < 8; ++e) lg[e] = 0.f;
#pragma unroll
            for (int j = 0; j < 4; ++j)
#pragma unroll
                for (int q = 0; q < 4; ++q) { const f32x4 r0 = rtr[j][q][0], r1 = rtr[j][q][1]; const float hv = v[j][q];
                    lg[0] += hv * r0[0]; lg[1] += hv * r0[1]; lg[2] += hv * r0[2]; lg[3] += hv * r0[3]; lg[4] += hv * r1[0]; lg[5] += hv * r1[1]; lg[6] += hv * r1[2]; lg[7] += hv * r1[3]; }
#pragma unroll
            for (int e = 0; e < 8; ++e) lg[e] = wave_sum(lg[e]);
            if (C.lane == 0) {
                int e0 = 0; float m0 = lg[0];
#pragma unroll
                for (int e = 1; e < 8; ++e) if (lg[e] > m0) { m0 = lg[e]; e0 = e; }
                int e1 = -1; float m1 = -3.0e38f;
#pragma unroll
                for (int e = 0; e < 8; ++e) if (e != e0 && lg[e] > m1) { m1 = lg[e]; e1 = e; }
                const float w0 = 1.f / (1.f + __expf(m1 - m0)), w1 = 1.f - w0;
                const int tk = (r / SA) * SQ + (r % SA) - CT;
                const int p0 = __hip_atomic_fetch_add(lcnt + e0, 1, __ATOMIC_RELAXED, __HIP_MEMORY_SCOPE_WORKGROUP), p1 = __hip_atomic_fetch_add(lcnt + e1, 1, __ATOMIC_RELAXED, __HIP_MEMORY_SCOPE_WORKGROUP);
                int* te = WSP(int, WS_TOK); float* tw = WSP(float, WS_TOK + 262144); int* tp = WSP(int, WS_TOK + 2 * 262144);
                te[2 * tk] = e0; te[2 * tk + 1] = e1; tw[2 * tk] = w0; tw[2 * tk + 1] = w1; tp[2 * tk] = p0; tp[2 * tk + 1] = p1;
            }
        }
      }
    }
    if (l == 1) {
        __syncthreads();
        if (C.tid < NEXP) { unsigned* cnt = (unsigned*)(C.ws + WS_CTL) + CW_MOECNT + C.tid * 64; WSP(int, WS_TOK + 4 * 262144)[C.vcu * NEXP + C.tid] = (int)atomicAdd(cnt, (unsigned)lcnt[C.tid]); }
    }
}
__device__ __forceinline__ void ph_ffn_up(Ctx& C) {
    pg8::Gemm g{C.ws + WS_H2_L0, C.ws + WS_WGU}; typedef pg8::Shape<1024, 1024, 1024> Sh;
    ListOrder<Dec2D> S{144 * 22, C.G, (int)blockIdx.x, Dec2D{144, 22, 0, 0}};
    EpiSwiGLU<WS_HID, FD> E{C.ws, 0, 1.f};
    pg8::gemm_phase<Sh>(C.lds, g, S, E);
}
__device__ __forceinline__ void ph_ffn_down(Ctx& C) {
    pg8::Gemm g{WSP(bf16, WS_HID), WSP(bf16, WS_WD)}; typedef pg8::Shape<FD, FD, FD> Sh;
    { ListOrder<Dec2D> S{128 * 4, C.G, (int)blockIdx.x, Dec2D{128, 4, 1, 0}};
      EpiPlain<WS_HN, 1024> E{C.ws};
      pg8::gemm_phase<Sh>(C.lds, g, S, E); }
    {
        RELAUNDER();
        pg8::Gemm g2{WSP(bf16, WS_HID), WSP(bf16, WS_WD)}; typedef pg8::Shape<FD, FD, FD / 2, FD / 2, FD / 2> Sh2;
        ListOrder<DecCtxK> S{128, C.G, (int)blockIdx.x, DecCtxK{}};
        EpiCtxPart E{C.ws};
        pg8::gemm_phase<Sh2>(C.lds, g2, S, E);
    }
}
__device__ __forceinline__ void ph_final0(Ctx& C) {
    const bf16* FFO = WSP(bf16, WS_HN);
    constexpr int NR = 3;
    ROWMAP_DECL();
    for (int k0 = 0; ROW_S(k0) < SA; k0 += NR) {
        f32x4 vv[NR][4], xx[NR][4];
#pragma unroll
        for (int q = 0; q < NR; ++q) { const int sx = ROW_S(k0 + q), r = rb_ * SA + sx; if (sx < SA) {
            if (sx < CT) { f32x4 t2[4]; const bf16* cp = WSP(bf16, WS_CPART) + (size_t)(rb_ * CT + sx) * 1024; load_row_bf16(vv[q], cp, C.lane); load_row_bf16(t2, cp + (size_t)4096 * 1024, C.lane);
#pragma unroll
                for (int j = 0; j < 4; ++j) vv[q][j] += t2[j]; }
            else load_row_bf16(vv[q], FFO + (size_t)r * 1024, C.lane);
            load_row_f32(xx[q], (const float*)xrow_cur(C, r), C.lane); } }
#pragma unroll
        for (int q = 0; q < NR; ++q) { const int sx = ROW_S(k0 + q), r = rb_ * SA + sx; if (sx >= SA) continue;
            row_post(vv[q], xx[q], C.in[9], modp(C, 0, r, 5), C.lane);
            store_row_f32(vv[q], xrow_cur(C, r), C.lane);
            row_norm_mod(vv[q], C.in[6] + 1024, modp(C, 1, r, 1), modp(C, 1, r, 0), WSP(bf16, WS_HN) + (size_t)r * 1024, C.lane); }
    }
    s5_build(C, 1);
}
struct MoeLayout { int off[NEXP + 1]; int pe[NEXP]; int np; };
__device__ __forceinline__ MoeLayout moe_layout(Ctx& C) {
    MoeLayout L; const unsigned* cnt = (const unsigned*)(C.ws + WS_CTL) + CW_MOECNT; int o = 0;
#pragma unroll
    for (int e = 0; e < NEXP; ++e) { L.off[e] = o; const int c = (int)__builtin_amdgcn_readfirstlane(__hip_atomic_load(cnt + e * 64, RLX_AGENT)); o += (c + 255) & ~255; L.pe[e] = o >> 8; }
    L.off[NEXP] = o; L.np = o >> 8; return L;
}
__device__ __forceinline__ void ph_moe_prep(Ctx& C) {
    {
        LAS float* scr = (LAS float*)(C.lds + C.wave * 16384);
        constexpr int I_G = 16 * 112, I_D = 56 * 32, I_E = 2 * I_G + I_D;
        for (int it = C.gw; it < NEXP * I_E; it += C.NGW) {
            const int e = it / I_E; int r = it % I_E; unsigned char* mw = C.ws + WS_MW + (size_t)e * MW_EXP;
            if (r < 2 * I_G) { const int up = r / I_G; r %= I_G; const int kb = r / 112, nb = r % 112;
                tr_item8(C.in[31 + up] + (size_t)e * 1024 * FE, FE, kb * 64, nb * 32, mw, 1024, (nb >> 2) * 256 + up * 128 + (nb & 3) * 32, MOE_WS, scr, C.lane); }
            else { r -= 2 * I_G; const int kb = r / 32, nb = r % 32; tr_item8(C.in[33] + (size_t)e * FE * 1024, 1024, kb * 64, nb * 32, mw + MW_D_OFF, FE, nb * 32, MOE_WS, scr, C.lane); }
        }
    }
    const MoeLayout L = moe_layout(C);
    const int* te = WSP(int, WS_TOK); const int* tp = WSP(int, WS_TOK + 2 * 262144); int* tsl = WSP(int, WS_TOK + 3 * 262144); const int* wgb = WSP(int, WS_TOK + 4 * 262144);
    const unsigned char* H2 = C.ws + WS_H2_L1; unsigned char* AS = C.ws + WS_ASORT;
    constexpr int NRS = 4;
    for (int t0 = C.gw; t0 < NB * SQ; t0 += NRS * C.NGW) {
      u32x2 aq[NRS], bq[NRS]; int eq[NRS][2], pq[NRS][2];
#pragma unroll
      for (int q = 0; q < NRS; ++q) { const int tk = t0 + q * C.NGW; if (tk < NB * SQ) { const int r = (tk / SQ) * SA + CT + (tk % SQ); const u32x2* src = (const u32x2*)(H2 + (size_t)r * 1024); aq[q] = src[C.lane]; bq[q] = src[C.lane + 64];
          eq[q][0] = te[2 * tk]; eq[q][1] = te[2 * tk + 1]; const int pw_ = ((tk / SQ) * (C.NGW / NB) + (CT + tk % SQ) % (C.NGW / NB)) >> 3; pq[q][0] = tp[2 * tk] + wgb[pw_ * NEXP + eq[q][0]]; pq[q][1] = tp[2 * tk + 1] + wgb[pw_ * NEXP + eq[q][1]]; } }
#pragma unroll
      for (int q = 0; q < NRS; ++q) { const int tk = t0 + q * C.NGW; if (tk >= NB * SQ) continue;
        const u32x2 a8 = aq[q], b8 = bq[q];
#pragma unroll
        for (int k = 0; k < 2; ++k) { const int e = eq[q][k]; int o = 0;
#pragma unroll
            for (int qq = 0; qq < NEXP; ++qq) o = (qq == e) ? L.off[qq] : o;
            const int slot = o + pq[q][k]; u32x2* dst = (u32x2*)(AS + (size_t)slot * 1024); dst[C.lane] = a8; dst[C.lane + 64] = b8;
            if (C.lane == 0) tsl[2 * tk + k] = slot; }
      }
    }
}
__device__ __forceinline__ void ph_moe_g(Ctx& C) {
    const MoeLayout L = moe_layout(C);
    pg8::Gemm g{C.ws + WS_ASORT, C.ws + WS_MW}; typedef pg8::Shape<1024, 1024, 1024, 0, (long)MW_EXP, 1> Sh;
    DecMoe dec; dec.p0 = 0; dec.np = L.np; dec.nN = 28;
#pragma unroll
    for (int e = 0; e < NEXP; ++e) dec.pe[e] = L.pe[e];
    ListOrder<DecMoe> S{L.np * 28, C.G, (int)blockIdx.x, dec};
    EpiSwiGLU8<WS_HIDC, FE> E{C.ws};
    pg8::gemm_phase<Sh>(C.lds, g, S, E);
}
__device__ __forceinline__ void ph_moe_d(Ctx& C) {
    const MoeLayout L = moe_layout(C);
    pg8::Gemm g{C.ws + WS_HIDC, C.ws + WS_MW + MW_D_OFF}; typedef pg8::Shape<FE, FE, FE, 0, (long)MW_EXP, 1> Sh;
    const int np1 = L.np < 256 ? L.np : 256;
    DecMoe dec; dec.p0 = 0; dec.np = np1; dec.nN = 4;
#pragma unroll
    for (int e = 0; e < NEXP; ++e) dec.pe[e] = L.pe[e];
    { ListOrder<DecMoe> S{np1 * 4, C.G, (int)blockIdx.x, dec};
      EpiMoeDown E{C.ws, -1};
      pg8::gemm_phase<Sh>(C.lds, g, S, E); }
    if (L.np > 256) {
        typedef pg8::Shape<FE, FE, FE / 2, 0, (long)MW_EXP, 1> Sh2; dec.p0 = 256; dec.np = L.np - 256;
#pragma unroll
        for (int kh = 0; kh < 2; ++kh) { RELAUNDER();
            pg8::Gemm g2{C.ws + WS_HIDC + kh * (FE / 2), C.ws + WS_MW + MW_D_OFF + kh * (FE / 2)};
            ListOrder<DecMoe> S{dec.np * 4, C.G, (int)blockIdx.x - 32 * kh, dec};
            EpiMoeDown E{C.ws, kh};
            pg8::gemm_phase<Sh2>(C.lds, g2, S, E); }
    }
}
__device__ __forceinline__ void ph_final1(Ctx& C) {
    const float* tw = WSP(float, WS_TOK + 262144); const int* tsl = WSP(int, WS_TOK + 3 * 262144); const bf16* Y = WSP(bf16, WS_Y);
    constexpr int NR = 4;
    ROWMAP_DECL();
    for (int k0 = 0; ROW_S(k0) < SQ; k0 += NR) {
        f32x4 y0[NR][4], y1[NR][4], x[NR][4]; int s0[NR], s1[NR]; float w0[NR], w1[NR];
#pragma unroll
        for (int q = 0; q < NR; ++q) { const int tx = ROW_S(k0 + q), tk = rb_ * SQ + tx; if (tx < SQ) { s0[q] = tsl[2 * tk]; s1[q] = tsl[2 * tk + 1]; w0[q] = tw[2 * tk]; w1[q] = tw[2 * tk + 1]; } }
#pragma unroll
        for (int q = 0; q < NR; ++q) { const int tx = ROW_S(k0 + q), tk = rb_ * SQ + tx; if (tx < SQ) { load_row_bf16(y0[q], Y + (size_t)s0[q] * 1024, C.lane); load_row_bf16(y1[q], Y + (size_t)s1[q] * 1024, C.lane); load_row_f32(x[q], C.out + (size_t)tk * 1024, C.lane);
            if (s0[q] >= 65536 || s1[q] >= 65536) { const bf16* Y2 = WSP(bf16, WS_Y2); f32x4 t2[4];
                if (s0[q] >= 65536) { load_row_bf16(y0[q], Y2 + (size_t)(s0[q] - 65536) * 1024, C.lane); load_row_bf16(t2, Y2 + (size_t)(s0[q] - 65536 + 2048) * 1024, C.lane);
#pragma unroll
                    for (int j = 0; j < 4; ++j) y0[q][j] += t2[j]; }
                if (s1[q] >= 65536) { load_row_bf16(y1[q], Y2 + (size_t)(s1[q] - 65536) * 1024, C.lane); load_row_bf16(t2, Y2 + (size_t)(s1[q] - 65536 + 2048) * 1024, C.lane);
#pragma unroll
                    for (int j = 0; j < 4; ++j) y1[q][j] += t2[j]; } } } }
#pragma unroll
        for (int q = 0; q < NR; ++q) { const int tx = ROW_S(k0 + q), tk = rb_ * SQ + tx; if (tx >= SQ) continue; const int r = rb_ * SA + CT + tx;
#pragma unroll
            for (int j = 0; j < 4; ++j) y0[q][j] = y0[q][j] * w0[q] + y1[q][j] * w1[q];
            row_post(y0[q], x[q], C.in[9] + 1024, modp(C, 1, r, 5), C.lane);
            store_row_f32(y0[q], C.out + (size_t)tk * 1024, C.lane); }
    }
}

#define MKCTX() Ctx C; { asm volatile("" ::: "memory"); int t_ = threadIdx.x; asm volatile("" : "+v"(t_)); long zw_ = 0, zo_ = 0; int z_ = 0; asm volatile("" : "+s"(zw_), "+s"(zo_), "+s"(z_)); unsigned char* w_ = args.ws + zw_; float* o_ = args.out + zo_; \
    C.lds = (LAS unsigned char*)lds; C.ldsg = (char*)lds; C.tid = t_; C.lane = t_ & 63; C.wave = __builtin_amdgcn_readfirstlane(t_ >> 6); \
    C.G = gridDim.x; { int bx = blockIdx.x; asm volatile("" : "+s"(bx)); C.vcu = (C.G % 8 == 0) ? (bx % 8) * (C.G / 8) + bx / 8 : bx; } \
    C.gw = C.vcu * 8 + C.wave; C.NGW = C.G * 8; C.ws = w_; C.ws0 = args.ws; C.in = args.in + z_; C.out = o_; }
__global__ void __launch_bounds__(512, 2) mk_fwd(Args args) {
    extern __shared__ __attribute__((aligned(16))) unsigned char lds[];
    volatile LAS unsigned* MISC = (volatile LAS unsigned*)((LAS unsigned char*)lds + MISC_OFF);
    for (int u = threadIdx.x; u < (LDS_BYTES - RING_BYTES) / 4; u += 512) ((LAS unsigned*)((LAS unsigned char*)lds + RING_BYTES))[u] = 0u;
    __syncthreads();
    const int lo = args.ph_lo, hi = args.ph_hi;
    XcdBarrier bar; bar.bar = (unsigned*)(args.ws + WS_CTL) + CW_BAR; bar.x = 0; bar.st = nullptr;
    if (hi - lo > 1) bar = xcd_barrier_post((unsigned*)(args.ws + WS_CTL) + CW_BAR, MISC + 8);
#define IN(k) (lo <= (k) && (k) < hi)
#define SEAM(k) do { if (IN(k) && IN((k) + 1)) { xcd_barrier(bar); } } while (0)
    if (IN(0)) { MKCTX(); ph_pre_a(C); } SEAM(0);
    if (IN(1)) { MKCTX(); ph_pre_b(C); } SEAM(1);
#define LAYER_COMMON(l) do { constexpr int pb = 2 + (l) * 10; \
        if (IN(pb + 0)) { MKCTX(); ph_win(C, l); } SEAM(pb + 0); \
        if (IN(pb + 1)) { MKCTX(); ph_mix(C, l); } SEAM(pb + 1); \
        if (IN(pb + 2)) { MKCTX(); ph_carry(C, l); } SEAM(pb + 2); \
        if (IN(pb + 3)) { MKCTX(); ph_s5g2(C, l); } SEAM(pb + 3); \
        if (IN(pb + 4)) { MKCTX(); ph_glu(C, l); } SEAM(pb + 4); \
        if (IN(pb + 5)) { MKCTX(); ph_wout(C, l); } SEAM(pb + 5); \
        if (IN(pb + 6)) { MKCTX(); ph_norm2<l>(C); } SEAM(pb + 6); } while (0)
    LAYER_COMMON(0);
    if (IN(9)) { MKCTX(); ph_ffn_up(C); } SEAM(9);
    if (IN(10)) { MKCTX(); ph_ffn_down(C); } SEAM(10);
    if (IN(11)) { MKCTX(); ph_final0(C); } SEAM(11);
    LAYER_COMMON(1);
    if (IN(19)) { MKCTX(); ph_moe_prep(C); } SEAM(19);
    if (IN(20)) { MKCTX(); ph_moe_g(C); } SEAM(20);
    if (IN(21)) { MKCTX(); ph_moe_d(C); } SEAM(21);
    if (IN(22)) { MKCTX(); ph_final1(C); }
#undef IN
#undef SEAM
}

extern "C" void kernel_launch(void* const* d_in, const int* in_sizes, int n_in, void* d_out, int out_size, void* d_ws, size_t ws_size, hipStream_t stream) {
    static int grid = 0;
    if (grid == 0) {
        if (n_in != 34 || out_size != NB * SQ * DM || ws_size < WS_END) { fprintf(stderr, "kernel_launch: unexpected shapes: n_in %d out %d ws %zu (need %zu)\n", n_in, out_size, ws_size, (size_t)WS_END); grid = -1; return; }
        int dev = 0, cus = 0, per_cu = 0;
        if (hipGetDevice(&dev) != hipSuccess || hipDeviceGetAttribute(&cus, hipDeviceAttributeMultiprocessorCount, dev) != hipSuccess) { grid = -1; return; }
        if (hipFuncSetAttribute((const void*)mk_fwd, hipFuncAttributeMaxDynamicSharedMemorySize, LDS_BYTES) != hipSuccess) { fprintf(stderr, "kernel_launch: hipFuncSetAttribute failed\n"); grid = -1; return; }
        if (hipOccupancyMaxActiveBlocksPerMultiprocessor(&per_cu, (const void*)mk_fwd, 512, LDS_BYTES) != hipSuccess || per_cu < 1) fprintf(stderr, "kernel_launch: occupancy query reports %d\n", per_cu);
        (void)hipGetLastError();
        grid = cus;
    }
    if (grid < 0) return;
    (void)hipMemsetAsync((char*)d_ws + WS_CTL, 0, CTL_ZERO_BYTES, stream);
    Args a{};
    for (int i = 0; i < 34; ++i) a.in[i] = (const float*)d_in[i];
    a.out = (float*)d_out; a.ws = (unsigned char*)d_ws;
#if MK_ONE_LAUNCH
    a.ph_lo = 0; a.ph_hi = NPHASE;
    hipLaunchKernelGGL(mk_fwd, dim3(grid), dim3(512), LDS_BYTES, stream, a);
#else
    for (int p = 0; p < NPHASE; ++p) { a.ph_lo = p; a.ph_hi = p + 1; hipLaunchKernelGGL(mk_fwd, dim3(grid), dim3(512), LDS_BYTES, stream, a); }
#endif
    const hipError_t le = hipPeekAtLastError();
    if (le != hipSuccess) fprintf(stderr, "kernel_launch: launch failed: %s\n", hipGetErrorName(le));
}
```

```cpp
#include <hip/hip_runtime.h>
#include <cstdio>
#include <cstdint>

#ifndef MK_ONE_LAUNCH
#define MK_ONE_LAUNCH 1
#endif

#define GAS __attribute__((address_space(1)))
#define LAS __attribute__((address_space(3)))
typedef unsigned short bf16;
typedef short bf16x8 __attribute__((ext_vector_type(8)));
typedef short s16x4 __attribute__((ext_vector_type(4)));
typedef float f32x2 __attribute__((ext_vector_type(2)));
typedef float f32x4 __attribute__((ext_vector_type(4)));
typedef float f32x8 __attribute__((ext_vector_type(8)));
typedef float f32x16 __attribute__((ext_vector_type(16)));
typedef unsigned u32x2 __attribute__((ext_vector_type(2)));
typedef unsigned u32x4 __attribute__((ext_vector_type(4)));

constexpr int NB = 16, SQ = 2048, CT = 256, SA = 2304, MR = NB * SA, DM = 1024;
constexpr int NWIN = 2304;
constexpr int FD = 2816, FE = 3584, NEXP = 8;
constexpr int CHT = 16;
constexpr int NCH = 144;
constexpr int S5ROWS = 2304;
constexpr int S5K1 = 256, S5K2 = 512;
constexpr int NP_CAP = 264;
constexpr float EPS = 1e-6f;

constexpr size_t MiB = 1u << 20;
constexpr size_t WS_CTL = 0, CTL_ZERO_BYTES = 1 * MiB;
constexpr size_t WS_MODS = 1 * MiB;
constexpr size_t WS_WCWS = 2 * MiB;
constexpr size_t WS_ROPE = 3 * MiB;
constexpr size_t WS_TOK = 4 * MiB;
constexpr size_t WS_S5POW = 6 * MiB;
constexpr size_t WS_S5POWT = 9 * MiB;
constexpr size_t WS_WIN = 16 * MiB;
constexpr size_t WS_WOUT = 25 * MiB;
constexpr size_t WS_WGU = 29 * MiB;
constexpr size_t WS_WD = 40 * MiB;
constexpr size_t WS_GLU = 46 * MiB;
constexpr size_t WS_DFTC = 46 * MiB + 512 * 1024;
constexpr size_t WS_DFTL = 47 * MiB;
constexpr size_t WS_KIN = 80 * MiB;
constexpr size_t WS_KTOT = 82 * MiB;
constexpr size_t WS_HN = 130 * MiB;
constexpr size_t WS_Q = 202 * MiB, WS_K = 238 * MiB, WS_V = 274 * MiB;
constexpr size_t WS_FT2 = 310 * MiB;
constexpr size_t WS_FTC = 342 * MiB;
constexpr size_t WS_UA = 346 * MiB;
constexpr size_t WS_HLOC = 88 * MiB;
constexpr size_t WS_AO = 390 * MiB;
constexpr size_t WS_CAT = 462 * MiB;
constexpr size_t WS_YY = 534 * MiB;
constexpr size_t WS_X1C = 552 * MiB;
constexpr size_t WS_H2_L0 = 202 * MiB;
constexpr size_t WS_HID = 274 * MiB;
constexpr size_t WS_MW = 16 * MiB;
constexpr size_t MW_EXP = 10 * MiB + 512 * 1024, MW_D_OFF = 7 * MiB;
constexpr size_t WS_ASORT = 100 * MiB;
constexpr size_t WS_Y = 100 * MiB;
constexpr size_t WS_XB1 = 232 * MiB;
constexpr size_t WS_HIDC = 298 * MiB;
constexpr size_t WS_H2_L1 = 316 * MiB;
constexpr size_t WS_CPART = 238 * MiB;
constexpr size_t WS_Y2 = 529 * MiB;
constexpr size_t WS_END = 568 * MiB;
constexpr float MOE_WS = 64.f, MOE_AS = 16.f, MOE_HS = 4.f;

constexpr int CW_TMO = 0, CW_CODE = 1, CW_MOECNT = 1024  , CW_BAR = 4096;

#define LDS_WAIT() asm volatile("s_waitcnt lgkmcnt(0)" ::: "memory")
#define VM_WAIT() asm volatile("s_waitcnt vmcnt(0)" ::: "memory")
#define RLX_AGENT __ATOMIC_RELAXED, __HIP_MEMORY_SCOPE_AGENT
__device__ __forceinline__ unsigned cvt_pk_bf16(float lo, float hi) { unsigned r; asm volatile("v_cvt_pk_bf16_f32 %0, %1, %2" : "=v"(r) : "v"(lo), "v"(hi)); return r; }
__device__ __forceinline__ float sat8(float x) { return __builtin_amdgcn_fmed3f(x, -448.f, 448.f); }
__device__ __forceinline__ unsigned cvt4_fp8(float a, float b, float c, float d) { int r = __builtin_amdgcn_cvt_pk_fp8_f32(a, b, 0, false); r = __builtin_amdgcn_cvt_pk_fp8_f32(c, d, r, true); return (unsigned)r; }
__device__ __forceinline__ unsigned cvt4_fp8_sat(float a, float b, float c, float d) { return cvt4_fp8(sat8(a), sat8(b), sat8(c), sat8(d)); }
__device__ __forceinline__ float bf2f(unsigned short b) { return __uint_as_float(((unsigned)b) << 16); }
__device__ __forceinline__ float bflo(unsigned w) { return __uint_as_float(w << 16); }
__device__ __forceinline__ float bfhi(unsigned w) { return __uint_as_float(w & 0xffff0000u); }
__device__ __forceinline__ float wave_sum(float v) {
#pragma unroll
    for (int o = 1; o < 64; o <<= 1) v += __shfl_xor(v, o);
    return v;
}
__device__ __forceinline__ float fsilu(float x) { return x * __builtin_amdgcn_rcpf(1.f + __builtin_amdgcn_exp2f(x * -1.4426950408889634f)); }
__device__ __forceinline__ float fsigm(float x) { return __builtin_amdgcn_rcpf(1.f + __builtin_amdgcn_exp2f(x * -1.4426950408889634f)); }
__device__ __forceinline__ float fgelu_tanh(float x) { const float u = x * (0.7978845608028654f + 0.035677408136300125f * x * x); return x * __builtin_amdgcn_rcpf(1.f + __builtin_amdgcn_exp2f(u * -2.885390081777927f)); }
__device__ __forceinline__ float sinrev(float r) { return __builtin_amdgcn_sinf(r); }
__device__ __forceinline__ float cosrev(float r) { return __builtin_amdgcn_cosf(r); }

namespace pg8 {
#define PG8_LAS __attribute__((address_space(3)))
typedef unsigned short bf16_t;
constexpr int BM = 256, BK = 64, HALF = 128, HTB = HALF * BK * 2, STAGE_BYTES = 8 * HTB;
__host__ __device__ __forceinline__ int lds_byte(int r, int c) { const int st = (r >> 4) * 2 + (c >> 5), rr = r & 15, cc = c & 31, ob = rr * 64 + cc * 2; return st * 1024 + (ob ^ (((ob >> 9) & 1) << 5)); }
__host__ __device__ __forceinline__ void stage_rc(int b, int& R, int& C) { const int st = b / 1024, sb = b % 1024, swz = sb ^ (((sb >> 9) & 1) << 5); R = (st >> 1) * 16 + swz / 64; C = (st & 1) * 32 + (swz % 64) / 2; }
__host__ __device__ __forceinline__ int perm32(int rho) { const int n = rho >> 4, i = rho & 15; return 8 * (i >> 2) + 4 * n + (i & 3); }
struct Unit { int pm, pn, z; };
template <int LDA_, int LDB_, int K_, long SAZ_ = 0, long SBZ_ = 0, int ESZ_ = 2> struct Shape { static constexpr int LDA = LDA_, LDB = LDB_, K = K_, ESZ = ESZ_; static constexpr long SAZ = SAZ_, SBZ = SBZ_; };
struct Gemm { const void* A; const void* Bt; };
typedef int v8i32 __attribute__((ext_vector_type(8)));
typedef int i32x4_t __attribute__((ext_vector_type(4)));
template <class Sh, class Epi, class Sched>
__device__ __forceinline__ void gemm_phase(PG8_LAS unsigned char* lds, const Gemm g, const Sched& S, const Epi& E) {
    int tid = threadIdx.x; asm volatile("" : "+v"(tid));
    const int wid = __builtin_amdgcn_readfirstlane(tid >> 6), lane = tid & 63, wr = wid >> 2, wc = wid & 3, fr = lane & 15, fq = lane >> 4;
    constexpr int nt = Sh::K * Sh::ESZ / 128;
    unsigned voffA[2], voffB[2];
#pragma unroll
    for (int i = 0; i < 2; ++i) { int R, C; stage_rc(tid * 16 + i * 8192, R, C); const int Rb = Epi::PERM ? ((R & ~31) + perm32(R & 31)) : R;
        voffA[i] = (unsigned)(R * Sh::LDA * Sh::ESZ + C * 2); voffB[i] = (unsigned)(Rb * Sh::LDB * Sh::ESZ + C * 2); }
    const size_t kstep = (size_t)(BK * 2);
    constexpr size_t hsA = (size_t)HALF * Sh::LDA * Sh::ESZ, hsB = (size_t)HALF * Sh::LDB * Sh::ESZ;
    const unsigned ldsw = (unsigned)wid * 1024u;
    const int aoff = lds_byte(wr * 64 + fr, fq * 8), boff = lds_byte(wc * 32 + fr, fq * 8);
#define PG8_TA(u) ((const char*)g.A + ((size_t)(u).z * (size_t)Sh::SAZ + (size_t)(u).pm * BM * Sh::LDA) * Sh::ESZ)
#define PG8_TB(u) ((const char*)g.Bt + ((size_t)(u).z * (size_t)Sh::SBZ + (size_t)(u).pn * BM * Sh::LDB) * Sh::ESZ)
#define PG8_SA(b, h) (((b) * 2 + (h)) * HTB)
#define PG8_SB(b, h) ((4 + (b) * 2 + (h)) * HTB)
#define PG8_STAGE(bufoff, gbase, voff) do { _Pragma("unroll") for (int _i = 0; _i < 2; ++_i) \
        __builtin_amdgcn_global_load_lds((const unsigned*)((const char*)(gbase) + (voff)[_i]), (PG8_LAS unsigned*)(lds + (bufoff) + ldsw + _i * 8192), 16, 0, 0); } while (0)
#define PG8_LD8(p) __builtin_shufflevector(*(const PG8_LAS i32x4_t*)(p), *(const PG8_LAS i32x4_t*)((p) + 1024), 0, 1, 2, 3, 4, 5, 6, 7)
#define PG8_LDA(dst, b, h) do { _Pragma("unroll") for (int m = 0; m < 4; ++m) dst[m] = PG8_LD8(lds + PG8_SA(b, h) + aoff + m * 2048); } while (0)
#define PG8_LDB(dst, b, h) do { _Pragma("unroll") for (int n = 0; n < 2; ++n) dst[n] = PG8_LD8(lds + PG8_SB(b, h) + boff + n * 2048); } while (0)
#define PG8_LO(x) __builtin_bit_cast(bf16x8, __builtin_shufflevector((x), (x), 0, 1, 2, 3))
#define PG8_HI(x) __builtin_bit_cast(bf16x8, __builtin_shufflevector((x), (x), 4, 5, 6, 7))
#define PG8_MMA(ai, bj, At, Bt) do { __builtin_amdgcn_s_setprio(1); \
        if constexpr (Sh::ESZ == 1) { _Pragma("unroll") for (int m = 0; m < 4; ++m) _Pragma("unroll") for (int n = 0; n < 2; ++n) \
            asm volatile("v_mfma_scale_f32_16x16x128_f8f6f4 %0, %1, %2, %0, %3, %3 op_sel_hi:[0,0,0]" : "+v"(acc[ai][bj][m][n]) : "v"(Bt[n]), "v"(At[m]), "v"(sc127)); } \
        else { _Pragma("unroll") for (int m = 0; m < 4; ++m) _Pragma("unroll") for (int n = 0; n < 2; ++n) { \
            acc[ai][bj][m][n] = __builtin_amdgcn_mfma_f32_16x16x32_bf16(PG8_LO(Bt[n]), PG8_LO(At[m]), acc[ai][bj][m][n], 0, 0, 0); \
            acc[ai][bj][m][n] = __builtin_amdgcn_mfma_f32_16x16x32_bf16(PG8_HI(Bt[n]), PG8_HI(At[m]), acc[ai][bj][m][n], 0, 0, 0); } } \
        __builtin_amdgcn_s_setprio(0); } while (0)
#define PG8_WAIT_V(n) asm volatile("s_waitcnt vmcnt(" #n ")" ::: "memory")
#define PG8_WAIT_L(n) asm volatile("s_waitcnt lgkmcnt(" #n ")" ::: "memory")
#define PG8_BAR __builtin_amdgcn_s_barrier()
#define PG8_SCHED __builtin_amdgcn_sched_barrier(0)
    Unit cur, nxt; int ui = 0;
    if (!S.next(0, cur)) return;
    f32x4 acc[2][2][4][2];
#pragma unroll
    for (int a = 0; a < 2; ++a)
#pragma unroll
        for (int b = 0; b < 2; ++b)
#pragma unroll
            for (int m = 0; m < 4; ++m)
#pragma unroll
                for (int n = 0; n < 2; ++n) acc[a][b][m][n] = (f32x4){0.f, 0.f, 0.f, 0.f};
    v8i32 At[4], B0[2], B1[2]; int sc127 = 0x7f7f7f7f; asm volatile("" : "+v"(sc127));
    const char* cA = PG8_TA(cur); const char* cB = PG8_TB(cur);
    PG8_STAGE(PG8_SB(0, 0), cB, voffB); PG8_STAGE(PG8_SB(0, 1), cB + hsB, voffB); PG8_STAGE(PG8_SA(0, 0), cA, voffA); PG8_STAGE(PG8_SA(0, 1), cA + hsA, voffA);
    if (wr == 1) PG8_BAR;
    PG8_WAIT_V(2); PG8_BAR;
    PG8_STAGE(PG8_SB(1, 0), cB + kstep, voffB); PG8_STAGE(PG8_SA(1, 0), cA + kstep, voffA); PG8_STAGE(PG8_SB(1, 1), cB + hsB + kstep, voffB);
    PG8_WAIT_V(6); PG8_BAR;
    for (;;) {
        const bool has_next = S.next(ui + 1, nxt);
        const char* nA = has_next ? PG8_TA(nxt) : cA; const char* nB = has_next ? PG8_TB(nxt) : cB;
#pragma nounroll
        for (int t = 0; t < nt; t += 2) {
            const bool last = (t == nt - 2);
            const char* a1 = cA + (size_t)(t + 1) * kstep;
            const char* a2 = last ? nA : cA + (size_t)(t + 2) * kstep; const char* b2 = last ? nB : cB + (size_t)(t + 2) * kstep;
            const char* a3 = a2 + kstep; const char* b3 = b2 + kstep;
            PG8_LDB(B0, 0, 0); PG8_LDB(B1, 0, 1); PG8_SCHED; PG8_LDA(At, 0, 0); PG8_STAGE(PG8_SA(1, 1), a1 + hsA, voffA);
            PG8_WAIT_V(8); PG8_WAIT_L(0); PG8_BAR; PG8_MMA(0, 0, At, B0); PG8_MMA(0, 1, At, B1); PG8_BAR; PG8_SCHED;
            PG8_LDA(At, 0, 1); PG8_STAGE(PG8_SB(0, 0), b2, voffB); PG8_STAGE(PG8_SB(0, 1), b2 + hsB, voffB); PG8_STAGE(PG8_SA(0, 0), a2, voffA);
            PG8_WAIT_V(8); PG8_WAIT_L(0); PG8_BAR; PG8_MMA(1, 0, At, B0); PG8_MMA(1, 1, At, B1); PG8_BAR; PG8_SCHED;
            PG8_LDB(B0, 1, 0); PG8_LDB(B1, 1, 1); PG8_SCHED; PG8_LDA(At, 1, 0); PG8_STAGE(PG8_SA(0, 1), a2 + hsA, voffA);
            PG8_WAIT_V(8); PG8_WAIT_L(0); PG8_BAR; PG8_MMA(0, 0, At, B0); PG8_MMA(0, 1, At, B1); PG8_BAR; PG8_SCHED;
            PG8_LDA(At, 1, 1); PG8_STAGE(PG8_SB(1, 0), b3, voffB); PG8_STAGE(PG8_SB(1, 1), b3 + hsB, voffB); PG8_STAGE(PG8_SA(1, 0), a3, voffA);
            PG8_WAIT_V(8); PG8_WAIT_L(0); PG8_BAR; PG8_MMA(1, 0, At, B0); PG8_MMA(1, 1, At, B1); PG8_BAR; PG8_SCHED;
        }
        if (wr == 0) PG8_BAR;
        if constexpr (Sh::ESZ == 1) asm volatile("s_nop 15\n\ts_nop 15" ::: "memory");
        E(acc, cur, wr, wc, fr, fq);
        if (!has_next) break;
#pragma unroll
        for (int a = 0; a < 2; ++a)
#pragma unroll
            for (int b = 0; b < 2; ++b)
#pragma unroll
                for (int m = 0; m < 4; ++m)
#pragma unroll
                    for (int n = 0; n < 2; ++n) acc[a][b][m][n] = (f32x4){0.f, 0.f, 0.f, 0.f};
        cur = nxt; cA = nA; cB = nB; ++ui;
        if (wr == 1) PG8_BAR;
    }
    PG8_WAIT_V(0);
    PG8_BAR;
#undef PG8_TA
#undef PG8_TB
#undef PG8_SA
#undef PG8_SB
#undef PG8_STAGE
#undef PG8_LDA
#undef PG8_LDB
#undef PG8_MMA
#undef PG8_LD8
#undef PG8_LO
#undef PG8_HI
#undef PG8_WAIT_V
#undef PG8_WAIT_L
#undef PG8_BAR
#undef PG8_SCHED
}
}

template <class Dec> struct ListOrder {
    int n, G, c; Dec dec;
    __device__ __forceinline__ bool next(int i, pg8::Unit& u) const { const long L = (long)i * G + c; if (c < 0 || L >= n) return false; dec((int)L, u); return true; }
};
__device__ __forceinline__ int lat_tile(int i) { return (i >> 3) * 9 + 1 + (i & 7); }
struct Dec2D {
    int nM, nN, latM, latN;
    __device__ __forceinline__ void operator()(int L, pg8::Unit& u) const {
        const int nwg = nM * nN; int wgid = L; { const int q = nwg / 8, r = nwg % 8, xcd = wgid % 8, off = wgid / 8; wgid = (xcd < r ? xcd * (q + 1) : r * (q + 1) + (xcd - r) * q) + off; }
        const int nig = 8 * nN, gid = wgid / nig, fm = gid * 8, gsz = (nM - fm) < 8 ? (nM - fm) : 8;
        int pm = fm + ((wgid % nig) % gsz), pn = (wgid % nig) / gsz;
        if (latM) pm = lat_tile(pm); if (latN) pn = lat_tile(pn);
        u.pm = pm; u.pn = pn; u.z = 0;
    }
};
struct DecWin1 {
    __device__ __forceinline__ void operator()(int L, pg8::Unit& u) const { if (L < 896) { Dec2D d{128, 7, 1, 0}; d(L, u); } else { const int r = L - 896; u.pm = (r / 5) * 9; u.pn = 2 + r % 5; u.z = 0; } } };
__device__ __forceinline__ void ft_row(int p, int& cs, int& ch) { const int g = (p >> 6) & 3, rr = p & 63; int j;
    if (p < 256) { if (rr <= 32) { cs = 0; j = rr; } else { cs = 1; j = rr - 32; } }
    else { if (rr <= 30) { cs = 0; j = rr + 33; } else { cs = 1; j = (rr + 1) & 63; } }
    ch = g * 64 + j; }
struct DecFT0 {
    __device__ __forceinline__ void operator()(int L, pg8::Unit& u) const { u.z = 0; if (L < 128) { u.pm = 0; u.pn = lat_tile(L); } else { const int q = L - 128; u.pm = q & 1; u.pn = (q >> 1) * 9; } } };
struct DecCtxK {
    __device__ __forceinline__ void operator()(int L, pg8::Unit& u) const { u.z = L >> 6; const int r = L & 63; u.pm = (r >> 2) * 9; u.pn = r & 3; } };
struct DecCtxK4 {
    __device__ __forceinline__ void operator()(int L, pg8::Unit& u) const { u.z = L >> 6; const int r = L & 63; u.pm = (r >> 2) * 9; u.pn = r & 3; } };
struct DecBatch { int nM, nN;
    __device__ __forceinline__ void operator()(int L, pg8::Unit& u) const { const int per = nM * nN; u.z = L / per; const int r = L % per; u.pm = r % nM; u.pn = r / nM; } };
struct DecMoe { int p0, np, nN; int pe[NEXP];
    __device__ __forceinline__ void operator()(int L, pg8::Unit& u) const {
        const int nig = 8 * nN, gid = L / nig, fm = gid * 8, gsz = (np - fm) < 8 ? (np - fm) : 8;
        const int pm = p0 + fm + ((L % nig) % gsz); u.pm = pm; u.pn = (L % nig) / gsz; int z = 0;
#pragma unroll
        for (int e = 0; e < NEXP - 1; ++e) z += (pm >= pe[e]) ? 1 : 0;
        u.z = z;
    }
};

__device__ __forceinline__ f32x2 swiglu_pk(f32x2 g, f32x2 u, float c1, float kk) {
    const f32x2 t = g * c1; f32x2 e; e.x = __builtin_amdgcn_exp2f(t.x); e.y = __builtin_amdgcn_exp2f(t.y);
    const f32x2 d = e * kk + kk; f32x2 r; r.x = __builtin_amdgcn_rcpf(d.x); r.y = __builtin_amdgcn_rcpf(d.y);
    return (g * u) * r;
}
typedef const f32x4 (&AccRef)[2][2][4][2];
#define EPI_LOOP_AM for (int ai = 0; ai < 2; ++ai) _Pragma("unroll") for (int m = 0; m < 4; ++m)
__device__ __forceinline__ u32x4 pack8(f32x4 v0, f32x4 v1) { u32x4 w; w.x = cvt_pk_bf16(v0[0], v0[1]); w.y = cvt_pk_bf16(v0[2], v0[3]); w.z = cvt_pk_bf16(v1[0], v1[1]); w.w = cvt_pk_bf16(v1[2], v1[3]); return w; }

template <size_t OFF, int LDC> struct EpiPlain {
    static constexpr bool PERM = true;
    unsigned char* ws;
    __device__ __forceinline__ void operator()(AccRef acc, const pg8::Unit& u, int wr, int wc, int fr, int fq) const {
        const int row0 = u.pm * 256 + wr * 64 + fr, col0 = u.pn * 256 + wc * 32 + 8 * fq; bf16* base = (bf16*)(ws + OFF);
#pragma unroll
        EPI_LOOP_AM { bf16* rowp = base + (size_t)(row0 + ai * 128 + m * 16) * LDC + col0;
#pragma unroll
            for (int bj = 0; bj < 2; ++bj) *(u32x4*)(rowp + bj * 128) = pack8(acc[ai][bj][m][0], acc[ai][bj][m][1]); }
    }
};
struct EpiCtxPart {
    static constexpr bool PERM = true;
    unsigned char* ws; int zoff;
    __device__ __forceinline__ void operator()(AccRef acc, const pg8::Unit& u, int wr, int wc, int fr, int fq) const {
        const int row0 = (u.pm / 9) * 256 + wr * 64 + fr, col0 = u.pn * 256 + wc * 32 + 8 * fq; bf16* base = (bf16*)(ws + WS_CPART) + (size_t)(u.z + zoff) * 4096 * 1024;
#pragma unroll
        EPI_LOOP_AM { bf16* rowp = base + (size_t)(row0 + ai * 128 + m * 16) * 1024 + col0;
#pragma unroll
            for (int bj = 0; bj < 2; ++bj) *(u32x4*)(rowp + bj * 128) = pack8(acc[ai][bj][m][0], acc[ai][bj][m][1]); }
    }
};
template <size_t OFF, int LDC, long SZ> struct EpiF32z {
    static constexpr bool PERM = false;
    unsigned char* ws;
    __device__ __forceinline__ void operator()(AccRef acc, const pg8::Unit& u, int wr, int wc, int fr, int fq) const {
        const int row0 = u.pm * 256 + wr * 64 + fr, col0 = u.pn * 256 + wc * 32 + 4 * fq; float* base = (float*)(ws + OFF) + (size_t)u.z * SZ;
#pragma unroll
        EPI_LOOP_AM { float* rowp = base + (size_t)(row0 + ai * 128 + m * 16) * LDC + col0;
#pragma unroll
            for (int bj = 0; bj < 2; ++bj)
#pragma unroll
                for (int n = 0; n < 2; ++n) *(f32x4*)(rowp + bj * 128 + n * 16) = acc[ai][bj][m][n]; }
    }
};
struct EpiIn {
    static constexpr bool PERM = true;
    unsigned char* ws;
    const LAS float* ropel;
    __device__ __forceinline__ void operator()(AccRef acc, const pg8::Unit& u, int wr, int wc, int fr, int fq) const {
        const int b = u.pm / 9, j9 = u.pm % 9;
        if (u.pn < 4) {
            bf16* O = (bf16*)(ws + ((u.pn < 2) ? WS_Q : WS_K)); const LAS float* rope = ropel; const int colb = (u.pn & 1) * 256 + wc * 32 + 8 * fq; const bool rot = (j9 != 0); const int hsel = wc & 1;
#pragma unroll
            EPI_LOOP_AM { const int rl = ai * 128 + wr * 64 + m * 16 + fr; const int pos = hsel ? (m * 16 + fr) : ((j9 - 1) * 4 + 2 * ai + wr);
                f32x4 cs0 = (f32x4){1.f, 0.f, 1.f, 0.f}, cs1 = cs0;
                if (rot) { const LAS f32x4* tp = (const LAS f32x4*)(rope + (pos * 16 + 4 * fq) * 2); cs0 = tp[0]; cs1 = tp[1]; }
                bf16* rowp = O + (size_t)(u.pm * 256 + rl) * 512 + colb; const float qs = (u.pn < 2) ? 0.18033688011112042f : 1.f;
#pragma unroll
                for (int bj = 0; bj < 2; ++bj) { const f32x4 a0 = acc[ai][bj][m][0] * qs, a1 = acc[ai][bj][m][1] * qs; f32x4 o0, o1;
                    o0[0] = a0[0] * cs0[0] - a0[1] * cs0[1]; o0[1] = a0[1] * cs0[0] + a0[0] * cs0[1];
                    o0[2] = a0[2] * cs0[2] - a0[3] * cs0[3]; o0[3] = a0[3] * cs0[2] + a0[2] * cs0[3];
                    o1[0] = a1[0] * cs1[0] - a1[1] * cs1[1]; o1[1] = a1[1] * cs1[0] + a1[0] * cs1[1];
                    o1[2] = a1[2] * cs1[2] - a1[3] * cs1[3]; o1[3] = a1[3] * cs1[2] + a1[2] * cs1[3];
                    *(u32x4*)(rowp + bj * 128) = pack8(o0, o1); } }
        } else if (u.pn < 6) {
            const int colb = (u.pn - 4) * 256 + wc * 32 + 8 * fq;
#pragma unroll
            EPI_LOOP_AM { bf16* rowp = (bf16*)(ws + WS_V) + (size_t)(u.pm * 256 + ai * 128 + wr * 64 + m * 16 + fr) * 512 + colb;
#pragma unroll
                for (int bj = 0; bj < 2; ++bj) *(u32x4*)(rowp + bj * 128) = pack8(acc[ai][bj][m][0], acc[ai][bj][m][1]); }
        } else {
#pragma unroll
            EPI_LOOP_AM { const int chunk = b * NCH + j9 * 16 + 8 * ai + 4 * wr + m, tl = fr;
#pragma unroll
                for (int bj = 0; bj < 2; ++bj) { const int c = bj * 128 + wc * 32 + 8 * fq, gi = c >> 4, ch = c & 15;
                    *(u32x4*)((bf16*)(ws + WS_UA) + ((size_t)gi * S5ROWS + chunk) * S5K2 + tl * 16 + ch) = pack8(acc[ai][bj][m][0], acc[ai][bj][m][1]); } }
        }
    }
};
struct EpiFT {
    static constexpr bool PERM = true;
    unsigned char* ws;
    __device__ __forceinline__ void operator()(AccRef acc, const pg8::Unit& u, int wr, int wc, int fr, int fq) const {
        const int b = u.pn / 9, j9 = u.pn % 9;
#pragma unroll
        EPI_LOOP_AM { int cs, ch; ft_row(u.pm * 256 + ai * 128 + wr * 64 + m * 16 + fr, cs, ch);
#pragma unroll
            for (int bj = 0; bj < 2; ++bj) { const int tc = bj * 128 + wc * 32 + 8 * fq;
                bf16* p = (j9 == 0) ? (bf16*)(ws + WS_FTC) + ((size_t)(b * 256 + ch) * 512 + cs * 256 + tc) : (bf16*)(ws + WS_FT2) + ((size_t)(b * 256 + ch) * 4096 + cs * 2048 + (j9 - 1) * 256 + tc);
                *(u32x4*)p = pack8(acc[ai][bj][m][0], acc[ai][bj][m][1]); } }
    }
};
struct EpiDft {
    static constexpr bool PERM = true;
    unsigned char* ws; int row_off;
    __device__ __forceinline__ void operator()(AccRef acc, const pg8::Unit& u, int wr, int wc, int fr, int fq) const {
#pragma unroll
        EPI_LOOP_AM { const int k = u.pm * 256 + ai * 128 + wr * 64 + m * 16 + fr; bf16* rowp = (bf16*)(ws + WS_CAT) + (size_t)(u.pn * SA + row_off + k) * 1024 + 512 + wc * 32 + 8 * fq;
#pragma unroll
            for (int bj = 0; bj < 2; ++bj) *(u32x4*)(rowp + bj * 128) = pack8(acc[ai][bj][m][0], acc[ai][bj][m][1]); }
    }
};
struct EpiS5 {
    static constexpr bool PERM = true;
    unsigned char* ws; const float* Dv; int lat_only;
    __device__ __forceinline__ void operator()(AccRef acc, const pg8::Unit& u, int wr, int wc, int fr, int fq) const {
        const int ch0 = 8 * (fq & 1); f32x4 d0 = *(const f32x4*)(Dv + u.z * 16 + ch0), d1 = *(const f32x4*)(Dv + u.z * 16 + ch0 + 4);
#pragma unroll
        for (int ai = 0; ai < 2; ++ai) { u32x4 uwv[4][2];
#pragma unroll
            for (int m = 0; m < 4; ++m) { const int row = u.pm * 256 + ai * 128 + wr * 64 + m * 16 + fr;
#pragma unroll
                for (int bj = 0; bj < 2; ++bj) { const int n2 = u.pn * 256 + bj * 128 + wc * 32 + 8 * fq; uwv[m][bj] = *(const u32x4*)((const bf16*)(ws + WS_UA) + ((size_t)u.z * S5ROWS + row) * S5K2 + n2); } }
#pragma unroll
            for (int m = 0; m < 4; ++m) { const int row = u.pm * 256 + ai * 128 + wr * 64 + m * 16 + fr; const int b = row / NCH, c = row % NCH;
            if (!(lat_only && c < CT / CHT)) {
#pragma unroll
                for (int bj = 0; bj < 2; ++bj) { const int n2 = u.pn * 256 + bj * 128 + wc * 32 + 8 * fq, tl = n2 >> 4;
                    const u32x4 uw = uwv[m][bj];
                    f32x4 v0 = acc[ai][bj][m][0], v1 = acc[ai][bj][m][1];
                    v0[0] += d0[0] * bflo(uw.x); v0[1] += d0[1] * bfhi(uw.x); v0[2] += d0[2] * bflo(uw.y); v0[3] += d0[3] * bfhi(uw.y);
                    v1[0] += d1[0] * bflo(uw.z); v1[1] += d1[1] * bfhi(uw.z); v1[2] += d1[2] * bflo(uw.w); v1[3] += d1[3] * bfhi(uw.w);
#pragma unroll
                    for (int e = 0; e < 4; ++e) { v0[e] = fgelu_tanh(v0[e]); v1[e] = fgelu_tanh(v1[e]); }
                    *(u32x4*)((bf16*)(ws + WS_YY) + (size_t)(b * SA + c * CHT + tl) * 256 + u.z * 16 + ch0) = pack8(v0, v1); } }
            asm volatile("" ::: "memory"); } }
    }
};
struct EpiGlu {
    static constexpr bool PERM = true;
    unsigned char* ws;
    __device__ __forceinline__ void operator()(AccRef acc, const pg8::Unit& u, int wr, int wc, int fr, int fq) const {
#pragma unroll
        EPI_LOOP_AM { const size_t row = (size_t)(u.pm * 256 + ai * 128 + wr * 64 + m * 16 + fr);
#pragma unroll
            for (int bj = 0; bj < 2; ++bj) { const int n = bj * 128 + wc * 32 + 8 * fq; const u32x4 yw = *(const u32x4*)((const bf16*)(ws + WS_YY) + row * 256 + n);
                const f32x4 a0 = acc[ai][bj][m][0], a1 = acc[ai][bj][m][1]; f32x4 v0, v1;
                v0[0] = bflo(yw.x) * fsigm(a0[0]); v0[1] = bfhi(yw.x) * fsigm(a0[1]); v0[2] = bflo(yw.y) * fsigm(a0[2]); v0[3] = bfhi(yw.y) * fsigm(a0[3]);
                v1[0] = bflo(yw.z) * fsigm(a1[0]); v1[1] = bfhi(yw.z) * fsigm(a1[1]); v1[2] = bflo(yw.w) * fsigm(a1[2]); v1[3] = bfhi(yw.w) * fsigm(a1[3]);
                *(u32x4*)((bf16*)(ws + WS_CAT) + row * 1024 + 768 + n) = pack8(v0, v1); }
            asm volatile("" ::: "memory"); }
    }
};
template <size_t OFF, int LDH> struct EpiSwiGLU {
    static constexpr bool PERM = true;
    unsigned char* ws; int pm0; float si;
    __device__ __forceinline__ void operator()(AccRef acc, const pg8::Unit& u, int wr, int wc, int fr, int fq) const {
#pragma unroll
        EPI_LOOP_AM { const size_t row = (size_t)((u.pm - pm0) * 256 + ai * 128 + wr * 64 + m * 16 + fr); f32x4 v0, v1;
#pragma unroll
            for (int n = 0; n < 2; ++n) { const float c1 = -si * 1.4426950408889634f, kk = 1.f / (si * si); const f32x4 g = acc[ai][0][m][n], uu = acc[ai][1][m][n];
                const f32x2 a = swiglu_pk((f32x2){g[0], g[1]}, (f32x2){uu[0], uu[1]}, c1, kk), b = swiglu_pk((f32x2){g[2], g[3]}, (f32x2){uu[2], uu[3]}, c1, kk);
                f32x4& vo = n ? v1 : v0; vo[0] = a.x; vo[1] = a.y; vo[2] = b.x; vo[3] = b.y; }
            *(u32x4*)((bf16*)(ws + OFF) + row * LDH + u.pn * 128 + wc * 32 + 8 * fq) = pack8(v0, v1); }
    }
};
template <size_t OFF, int LDH> struct EpiSwiGLU8 {
    static constexpr bool PERM = true;
    unsigned char* ws;
    __device__ __forceinline__ void operator()(AccRef acc, const pg8::Unit& u, int wr, int wc, int fr, int fq) const {
        constexpr float si = 1.f / (MOE_AS * MOE_WS);
#pragma unroll
        EPI_LOOP_AM { const size_t row = (size_t)(u.pm * 256 + ai * 128 + wr * 64 + m * 16 + fr); float v[8];
#pragma unroll
            for (int n = 0; n < 2; ++n) { constexpr float c1 = -si * 1.4426950408889634f, kk = 1.f / (si * si * MOE_HS); const f32x4 g = acc[ai][0][m][n], uu = acc[ai][1][m][n];
                const f32x2 a = swiglu_pk((f32x2){g[0], g[1]}, (f32x2){uu[0], uu[1]}, c1, kk), b = swiglu_pk((f32x2){g[2], g[3]}, (f32x2){uu[2], uu[3]}, c1, kk);
                v[4 * n] = a.x; v[4 * n + 1] = a.y; v[4 * n + 2] = b.x; v[4 * n + 3] = b.y; }
            u32x2 o; o.x = cvt4_fp8_sat(v[0], v[1], v[2], v[3]); o.y = cvt4_fp8_sat(v[4], v[5], v[6], v[7]);
            *(u32x2*)(ws + OFF + row * LDH + u.pn * 128 + wc * 32 + 8 * fq) = o; }
    }
};
struct EpiMoeDown {
    static constexpr bool PERM = true;
    unsigned char* ws; int part;
    __device__ __forceinline__ void operator()(AccRef acc, const pg8::Unit& u, int wr, int wc, int fr, int fq) const {
        const int row0 = u.pm * 256 + wr * 64 + fr, col0 = u.pn * 256 + wc * 32 + 8 * fq;
        constexpr float so = 1.f / (MOE_HS * MOE_WS);
        bf16* yb = part < 0 ? (bf16*)(ws + WS_Y) : (bf16*)(ws + WS_Y2) + (size_t)part * 2048 * 1024 - (size_t)65536 * 1024;
#pragma unroll
        EPI_LOOP_AM { bf16* rowp = yb + (size_t)(row0 + ai * 128 + m * 16) * 1024 + col0;
#pragma unroll
            for (int bj = 0; bj < 2; ++bj) *(u32x4*)(rowp + bj * 128) = pack8(acc[ai][bj][m][0] * so, acc[ai][bj][m][1] * so); }
    }
};

namespace att {
constexpr int NW = 8, QBLK = 32, KVBLK = 64;
constexpr float SCALE = 0.125f, THR = 16.f;
constexpr int LDQ = 512, LDK = 512, LDV = 512, LDO = 1024;
constexpr int NSLOT = 2, SHM_V = KVBLK * 128 * 2, SHM_K = KVBLK * 64 * 2, SHM_ATTN = NSLOT * SHM_V + NSLOT * SHM_K + NW * 64 * 4;
#define KSWZ(row, colB) ((row) * 128 + ((colB) ^ ((((row) >> 1) & 7) << 4)))
#define SBAR() __builtin_amdgcn_sched_barrier(0)
__device__ __forceinline__ int crow(int r, int hi) { return (r & 3) + 8 * (r >> 2) + 4 * hi; }
template <bool FIRST> __device__ __forceinline__ void partialSM(f32x16& p0, f32x16& p1, float& m_reg, f32x16& negm, float& alpha) {
    constexpr float THR2 = THR * 1.4426950408889634f;
    float pmax = p0[0];
#pragma unroll
    for (int r = 1; r < 16; ++r) pmax = fmaxf(pmax, p0[r]);
#pragma unroll
    for (int r = 0; r < 16; ++r) pmax = fmaxf(pmax, p1[r]);
    { auto rr = __builtin_amdgcn_permlane32_swap(__float_as_uint(pmax), __float_as_uint(pmax), false, false);
      pmax = fmaxf(__uint_as_float(rr[0]), __uint_as_float(rr[1])); }
    alpha = 1.f;
    if (FIRST || __builtin_expect(__any(pmax > THR2), 0)) {
        const float dl = FIRST ? pmax : fmaxf(pmax, 0.f); m_reg += dl; alpha = __builtin_amdgcn_exp2f(-dl);
#pragma unroll
        for (int r = 0; r < 16; ++r) { p0[r] -= dl; p1[r] -= dl; }
#pragma unroll
        for (int r = 0; r < 16; ++r) negm[r] = -m_reg;
        asm volatile("" : "+v"(negm));
    }
#pragma unroll
    for (int r = 0; r < 16; ++r) p0[r] = __builtin_amdgcn_exp2f(p0[r]);
#pragma unroll
    for (int r = 0; r < 16; ++r) p1[r] = __builtin_amdgcn_exp2f(p1[r]);
}
__device__ __forceinline__ void finishSM(f32x16& p0, f32x16& p1, float alpha, float& l_reg, bf16x8& pa0, bf16x8& pa1, bf16x8& pa2, bf16x8& pa3) {
    float ps = 0;
#pragma unroll
    for (int r = 0; r < 16; ++r) ps += p0[r];
#pragma unroll
    for (int r = 0; r < 16; ++r) ps += p1[r];
    { auto rr = __builtin_amdgcn_permlane32_swap(__float_as_uint(ps), __float_as_uint(ps), false, false);
      ps = __uint_as_float(rr[0]) + __uint_as_float(rr[1]); }
    l_reg = l_reg * alpha + ps;
#define PK4(P, BASE, OUT) do { unsigned a0 = cvt_pk_bf16(P[BASE + 0], P[BASE + 1]), a1 = cvt_pk_bf16(P[BASE + 2], P[BASE + 3]);   \
    unsigned b0 = cvt_pk_bf16(P[BASE + 4], P[BASE + 5]), b1 = cvt_pk_bf16(P[BASE + 6], P[BASE + 7]);                              \
    auto r0 = __builtin_amdgcn_permlane32_swap(a0, b0, false, false); auto r1 = __builtin_amdgcn_permlane32_swap(a1, b1, false, false); \
    u32x4 w = {r0[0], r1[0], r0[1], r1[1]}; OUT = *reinterpret_cast<bf16x8*>(&w); } while (0)
    PK4(p0, 0, pa0); PK4(p0, 8, pa1); PK4(p1, 0, pa2); PK4(p1, 8, pa3);
#undef PK4
}
__device__ __forceinline__ void qkt(f32x16& p0, f32x16& p1, const char* Ks, const bf16x8* qr, const f32x16& negm, int r32, int hi) {
    p0 = negm; p1 = negm;
#pragma unroll
    for (int d0 = 0; d0 < 4; ++d0) { const int cb = d0 * 32 + hi * 16;
        const bf16x8 b0 = *reinterpret_cast<const bf16x8*>(Ks + KSWZ(r32, cb));
        const bf16x8 b1 = *reinterpret_cast<const bf16x8*>(Ks + KSWZ(32 + r32, cb));
        p0 = __builtin_amdgcn_mfma_f32_32x32x16_bf16(b0, qr[d0], p0, 0, 0, 0);
        p1 = __builtin_amdgcn_mfma_f32_32x32x16_bf16(b1, qr[d0], p1, 0, 0, 0); }
}
__device__ __forceinline__ int v_st(int k, int c) { const int kk = (k & ~0xC) | ((k & 4) << 1) | ((k & 8) >> 1); return ((kk >> 3) * 4 + (c >> 5)) * 512 + ((kk & 7) * 32 + (c & 31)) * 2; }
__device__ __forceinline__ int v_rd_base(int lane) { return ((lane & 3) << 3) | (((lane >> 2) & 3) << 6) | (((lane >> 4) & 1) << 5) | (((lane >> 5) & 1) << 8); }
constexpr int v_rd_off(int d0, int ks, int half) { return d0 * 512 + ks * 4096 + half * 2048; }
typedef short v4i16_t __attribute__((ext_vector_type(4)));
typedef const __attribute__((address_space(3))) char* lds_cptr;
template <int OFF> __device__ __forceinline__ s16x4 tr_read(lds_cptr vb) { return __builtin_bit_cast(s16x4, __builtin_amdgcn_ds_read_tr16_b64_v4i16((__attribute__((address_space(3))) v4i16_t*)(vb + OFF))); }
template <int D0> __device__ __forceinline__ void pv_one(f32x16& od, lds_cptr vb, bf16x8 pa0, bf16x8 pa1, bf16x8 pa2, bf16x8 pa3) {
    const s16x4 l0 = tr_read<v_rd_off(D0, 0, 0)>(vb), h0 = tr_read<v_rd_off(D0, 0, 1)>(vb), l1 = tr_read<v_rd_off(D0, 1, 0)>(vb), h1 = tr_read<v_rd_off(D0, 1, 1)>(vb);
    const s16x4 l2 = tr_read<v_rd_off(D0, 2, 0)>(vb), h2 = tr_read<v_rd_off(D0, 2, 1)>(vb), l3 = tr_read<v_rd_off(D0, 3, 0)>(vb), h3 = tr_read<v_rd_off(D0, 3, 1)>(vb);
#define PK(L, H) (bf16x8){L[0], L[1], L[2], L[3], H[0], H[1], H[2], H[3]}
    od = __builtin_amdgcn_mfma_f32_32x32x16_bf16(pa0, PK(l0, h0), od, 0, 0, 0);
    od = __builtin_amdgcn_mfma_f32_32x32x16_bf16(pa1, PK(l1, h1), od, 0, 0, 0);
    od = __builtin_amdgcn_mfma_f32_32x32x16_bf16(pa2, PK(l2, h2), od, 0, 0, 0);
    od = __builtin_amdgcn_mfma_f32_32x32x16_bf16(pa3, PK(l3, h3), od, 0, 0, 0);
#undef PK
}
__device__ __forceinline__ void pv_d0(f32x16* o, lds_cptr vb, bf16x8 pa0, bf16x8 pa1, bf16x8 pa2, bf16x8 pa3) {
    pv_one<0>(o[0], vb, pa0, pa1, pa2, pa3); pv_one<1>(o[1], vb, pa0, pa1, pa2, pa3); pv_one<2>(o[2], vb, pa0, pa1, pa2, pa3); pv_one<3>(o[3], vb, pa0, pa1, pa2, pa3);
}
template <bool FUSE> __device__ __forceinline__ void attn_unit(const bf16* __restrict__ Qb, const bf16* __restrict__ Kh, const bf16* __restrict__ Vh, bf16* Ob, int seq, char* lds, bf16* Cb = nullptr, float lamv = 0.f, float oml = 0.f, const float* sub = nullptr) {
    int tid = threadIdx.x; asm volatile("" : "+v"(tid));
    const int wid = tid >> 6, lane = tid & 63, r32 = lane & 31, hi = lane >> 5;
    char* V_lds = lds; char* K_lds = lds + NSLOT * SHM_V;
    float* ws = (float*)(lds + NSLOT * SHM_V + NSLOT * SHM_K) + wid * 64; float* li_l = ws; float* al_l = ws + 32;
    float m_reg = 0.f, l_reg = 0; f32x16 o[4] = {}; bf16x8 qr[4]; f32x16 negm = f32x16{}; asm volatile("" : "+v"(negm));
    const bf16* Qw = Qb + (long)(wid * QBLK + r32) * LDQ + hi * 8;
#pragma unroll
    for (int d0 = 0; d0 < 4; ++d0) qr[d0] = *reinterpret_cast<const bf16x8*>(Qw + d0 * 16);
    const int sr = tid >> 4, sc = (tid & 15) * 8, vst0 = v_st(sr, sc), vst1 = v_st(32 + sr, sc);
    const int kr = tid >> 3, kc = (tid & 7) * 8, kst = KSWZ(kr, kc * 2);
    const lds_cptr vb0 = (lds_cptr)V_lds + v_rd_base(lane);
    struct { bf16x8 vs0, vs1, ks; } sr_[2];
#define SLOAD(i, k0) do { sr_[i].vs0 = *reinterpret_cast<const bf16x8*>(&Vh[(long)((k0) + sr) * LDV + sc]); sr_[i].vs1 = *reinterpret_cast<const bf16x8*>(&Vh[(long)((k0) + 32 + sr) * LDV + sc]); \
    sr_[i].ks = *reinterpret_cast<const bf16x8*>(&Kh[(long)((k0) + kr) * LDK + kc]); } while (0)
#define SWRITE(b, i) do { *(bf16x8*)(V_lds + (b) * SHM_V + vst0) = sr_[i].vs0; *(bf16x8*)(V_lds + (b) * SHM_V + vst1) = sr_[i].vs1; \
    *(bf16x8*)(K_lds + (b) * SHM_K + kst) = sr_[i].ks; } while (0)
#define SWAIT() asm volatile("s_waitcnt vmcnt(3)" ::: "memory")
#define RESC(a) do { if (__any((a) < 1.f)) { if (hi == 0) al_l[r32] = (a); asm volatile("s_waitcnt lgkmcnt(0)" ::: "memory"); \
    _Pragma("unroll") for (int d = 0; d < 4; ++d) _Pragma("unroll") for (int r = 0; r < 16; ++r) o[d][r] *= al_l[crow(r, hi)]; } } while (0)
    f32x16 pA0, pA1, pB0, pB1; float alA, alB; bf16x8 pa0, pa1, pa2, pa3; const int NT = seq / KVBLK;
    constexpr int SE = 0, SO = 1;
    SLOAD(SE, 0); asm volatile("s_waitcnt vmcnt(0)" ::: "memory"); SWRITE(0, SE); __syncthreads();
    qkt(pA0, pA1, K_lds, qr, negm, r32, hi); partialSM<true>(pA0, pA1, m_reg, negm, alA);
    SLOAD(SO, KVBLK); if (2 < NT) SLOAD(SE, 2 * KVBLK);
    SWAIT(); SWRITE(1, SO); __syncthreads();
    for (int j = 1; j + 1 < NT; j += 2) {
        SBAR(); qkt(pB0, pB1, K_lds + SHM_K, qr, negm, r32, hi);
        finishSM(pA0, pA1, alA, l_reg, pa0, pa1, pa2, pa3); SBAR();
        SLOAD(SO, (j + 2) * KVBLK); SBAR();
        pv_d0(o, vb0, pa0, pa1, pa2, pa3); partialSM<false>(pB0, pB1, m_reg, negm, alB); SBAR();
        __syncthreads(); SWAIT(); SWRITE(0, SE);
        RESC(alB); __syncthreads();
        SBAR(); qkt(pA0, pA1, K_lds, qr, negm, r32, hi);
        finishSM(pB0, pB1, alB, l_reg, pa0, pa1, pa2, pa3); SBAR();
        if (j + 3 < NT) SLOAD(SE, (j + 3) * KVBLK); SBAR();
        pv_d0(o, vb0 + SHM_V, pa0, pa1, pa2, pa3); partialSM<false>(pA0, pA1, m_reg, negm, alA); SBAR();
        __syncthreads(); SWAIT(); SWRITE(1, SO);
        RESC(alA); __syncthreads();
    }
    SBAR(); qkt(pB0, pB1, K_lds + SHM_K, qr, negm, r32, hi);
    finishSM(pA0, pA1, alA, l_reg, pa0, pa1, pa2, pa3); SBAR();
    pv_d0(o, vb0, pa0, pa1, pa2, pa3); partialSM<false>(pB0, pB1, m_reg, negm, alB);
    __syncthreads(); RESC(alB);
    finishSM(pB0, pB1, alB, l_reg, pa0, pa1, pa2, pa3); SBAR();
    pv_d0(o, vb0 + SHM_V, pa0, pa1, pa2, pa3);
    if (hi == 0) li_l[r32] = l_reg; asm volatile("s_waitcnt lgkmcnt(0)" ::: "memory");
    float rli[16];
#pragma unroll
    for (int r = 0; r < 16; ++r) rli[r] = __builtin_amdgcn_rcpf(li_l[crow(r, hi)]);
    bf16* Ow = Ob + (long)(wid * QBLK) * LDO;
    __syncthreads();
    { bf16* stg = (bf16*)lds + wid * 4096;
#pragma unroll
      for (int r = 0; r < 16; ++r) { const int orow = crow(r, hi);
#pragma unroll
          for (int d0 = 0; d0 < 4; ++d0) stg[orow * 128 + d0 * 32 + r32] = (bf16)(cvt_pk_bf16(o[d0][r] * rli[r], 0.f) & 0xffffu); }
      asm volatile("s_waitcnt lgkmcnt(0)" ::: "memory");
      if constexpr (!FUSE) {
#pragma unroll
      for (int i = 0; i < 8; ++i) { const int row = i * 4 + (lane >> 4), ch = lane & 15; const u32x4 v = *(const u32x4*)(stg + row * 128 + ch * 8); *(GAS u32x4*)(Ow + (long)row * LDO + ch * 8) = v; }
      } else {
        const int ch = lane & 15; u32x4 o1v[8]; bf16* Cw = Cb + (long)(wid * QBLK) * 1024;
#pragma unroll
        for (int i = 0; i < 8; ++i) { const int row = i * 4 + (lane >> 4); o1v[i] = *(const GAS u32x4*)(Ow - 128 + (long)row * LDO + ch * 8); }
        const f32x4 s0 = *(const f32x4*)(sub + ch * 8), s1 = *(const f32x4*)(sub + ch * 8 + 4);
#pragma unroll
        for (int i = 0; i < 8; ++i) { const int row = i * 4 + (lane >> 4); const u32x4 bq = *(const u32x4*)(stg + row * 128 + ch * 8), a = o1v[i]; float v[8];
            v[0] = bflo(a.x) - lamv * bflo(bq.x); v[1] = bfhi(a.x) - lamv * bfhi(bq.x); v[2] = bflo(a.y) - lamv * bflo(bq.y); v[3] = bfhi(a.y) - lamv * bfhi(bq.y);
            v[4] = bflo(a.z) - lamv * bflo(bq.z); v[5] = bfhi(a.z) - lamv * bfhi(bq.z); v[6] = bflo(a.w) - lamv * bflo(bq.w); v[7] = bfhi(a.w) - lamv * bfhi(bq.w);
            float ss = 0.f;
#pragma unroll
            for (int e = 0; e < 8; ++e) ss += v[e] * v[e];
#pragma unroll
            for (int o2 = 1; o2 < 16; o2 <<= 1) ss += __shfl_xor(ss, o2);
            const float sc = rsqrtf(ss * (1.f / 128.f) + EPS) * oml;
            u32x4 w; w.x = cvt_pk_bf16(v[0] * sc * s0[0], v[1] * sc * s0[1]); w.y = cvt_pk_bf16(v[2] * sc * s0[2], v[3] * sc * s0[3]); w.z = cvt_pk_bf16(v[4] * sc * s1[0], v[5] * sc * s1[1]); w.w = cvt_pk_bf16(v[6] * sc * s1[2], v[7] * sc * s1[3]);
            *(GAS u32x4*)(Cw + (long)row * 1024 + ch * 8) = w; }
      } }
    __syncthreads();
#undef SLOAD
#undef SWRITE
#undef SWAIT
#undef RESC
}
#undef KSWZ
#undef SBAR
}

#define XB_TMO      128
#define XB_XCNT(j)  (256  + 64 * (j))
#define XB_XSUB(j)  (1280 + 64 * (j))
#define XB_XGEN(j)  (2304 + 64 * (j))
#define XB_TOP      3328
#define XB_TOPGEN   3392
#define XCD_BAR_WORDS 3456
#define XB_SPIN_CAP (1u << 18)
__device__ __forceinline__ unsigned xb_ld(unsigned* p)              { return __hip_atomic_load(p, __ATOMIC_RELAXED, __HIP_MEMORY_SCOPE_AGENT); }
__device__ __forceinline__ unsigned xb_add(unsigned* p, unsigned v) { return __hip_atomic_fetch_add(p, v, __ATOMIC_RELAXED, __HIP_MEMORY_SCOPE_AGENT); }
__device__ __forceinline__ unsigned xb_xcc_id() { return (unsigned)__builtin_amdgcn_s_getreg((3 << 11) | 20) & 0xFu; }
#define XB_SPIN(cond, bar) do { unsigned _sp = 0; while (cond) { __builtin_amdgcn_s_sleep(1); \
    if ((++_sp & 255u) == 0u) { if (xb_ld(&(bar)[XB_TMO])) break; if (_sp > XB_SPIN_CAP) { atomicAdd(&(bar)[XB_TMO], 1u); break; } } } } while (0)
struct XcdBarrier { unsigned* bar; unsigned x; volatile LAS unsigned* st; };
__device__ __forceinline__ XcdBarrier xcd_barrier_post(unsigned* bar, volatile LAS unsigned* st) {
    XcdBarrier b; b.bar = bar; b.x = xb_xcc_id(); b.st = st;
    if (threadIdx.x == 0) (void)xb_add(&bar[XB_XCNT(b.x)], 1u);
    return b;
}
__device__ __forceinline__ void xcd_barrier_complete(unsigned* bar, unsigned x, unsigned& nloc, unsigned& nx) {
    const unsigned G = gridDim.x * gridDim.y * gridDim.z;
    unsigned sum, cnt, mine, sp = 0u;
    for (;;) {
        sum = 0u; cnt = 0u; mine = 0u;
#pragma unroll
        for (unsigned j = 0; j < 16; ++j) { const unsigned c = xb_ld(&bar[XB_XCNT(j)]); sum += c; cnt += (c > 0u) ? 1u : 0u; mine = (j == x) ? c : mine; }
        if (sum == G) break;
        __builtin_amdgcn_s_sleep(1);
        if ((++sp & 255u) == 0u) { if (xb_ld(&bar[XB_TMO])) break; if (sp > XB_SPIN_CAP) { atomicAdd(&bar[XB_TMO], 1u); break; } }
    }
    nloc = mine > 0u ? mine : 1u; nx = cnt > 0u ? cnt : 1u;
}
__device__ __forceinline__ void xcd_barrier(const XcdBarrier& b) {
    asm volatile("s_waitcnt vmcnt(0)" ::: "memory");
    __syncthreads();
    if (threadIdx.x == 0) {
        unsigned* bar = b.bar;
        __builtin_amdgcn_s_waitcnt(0);
        unsigned nloc = b.st[0], nx = b.st[1];
        if (nloc == 0u) { xcd_barrier_complete(bar, b.x, nloc, nx); b.st[0] = nloc; b.st[1] = nx; }
        const unsigned old = xb_add(&bar[XB_XSUB(b.x)], 1u);
        const unsigned gen = old / nloc;
        if (old + 1u == (gen + 1u) * nloc) {
            __builtin_amdgcn_fence(__ATOMIC_RELEASE, "agent");
            asm volatile("s_waitcnt vmcnt(0)" ::: "memory");
            const unsigned og = xb_add(&bar[XB_TOP], 1u);
            const unsigned tg = og / nx;
            if (og + 1u == (tg + 1u) * nx) xb_add(&bar[XB_TOPGEN], 1u);
            else XB_SPIN(xb_ld(&bar[XB_TOPGEN]) == tg, bar);
            __builtin_amdgcn_fence(__ATOMIC_ACQUIRE, "agent");
            xb_add(&bar[XB_XGEN(b.x)], 1u);
            asm volatile("s_waitcnt vmcnt(0)" ::: "memory");
        } else {
            XB_SPIN(xb_ld(&bar[XB_XGEN(b.x)]) == gen, bar);
            __builtin_amdgcn_fence(__ATOMIC_ACQUIRE, "agent");
            asm volatile("s_waitcnt vmcnt(0)" ::: "memory");
        }
    }
    __syncthreads();
}

constexpr int RING_BYTES = 131072, MISC_OFF = RING_BYTES + 320, LDS_BYTES = 147456;
constexpr int NPHASE = 23;
struct Args { const float* in[34]; float* out; unsigned char* ws; int ph_lo, ph_hi; };

struct Ctx {
    LAS unsigned char* lds; char* ldsg;
    int tid, lane, wave, G, vcu, gw, NGW;
    unsigned char* ws; unsigned char* ws0; const float* const* in; float* out;
};
#define WSP(T, off) ((T*)(C.ws + (off)))
#define RELAUNDER() do { long zz_ = 0; asm volatile("" : "+s"(zz_)); C.ws = C.ws0 + zz_; asm volatile("" ::: "memory"); } while (0)

__device__ __forceinline__ void tr_item(const float* W, int ldw, int k0, int c0, bf16* WT, int ldt, int r0, int permqk, LAS float* scr, int lane) {
    float tv[32];
#pragma unroll
    for (int i = 0; i < 32; ++i) tv[i] = W[(size_t)(k0 + 2 * i + (lane >> 5)) * ldw + c0 + (lane & 31)];
#pragma unroll
    for (int i = 0; i < 32; ++i) scr[(2 * i + (lane >> 5)) * 33 + (lane & 31)] = tv[i];
    LDS_WAIT(); asm volatile("" ::: "memory");
    const int c = lane & 7;
#pragma unroll
    for (int j = 0; j < 4; ++j) { const int n = (lane >> 3) + 8 * j; const LAS float* s = scr + (8 * c) * 33 + n;
        u32x4 o; o.x = cvt_pk_bf16(s[0 * 33], s[1 * 33]); o.y = cvt_pk_bf16(s[2 * 33], s[3 * 33]); o.z = cvt_pk_bf16(s[4 * 33], s[5 * 33]); o.w = cvt_pk_bf16(s[6 * 33], s[7 * 33]);
        const int dn = permqk ? (2 * (n & 15) + (n >> 4)) : n;
        *(GAS u32x4*)(WT + (size_t)(r0 + dn) * ldt + k0 + 8 * c) = o; }
    LDS_WAIT(); asm volatile("" ::: "memory");
}

struct TrJob { const float* W; unsigned char* WT; int ldw, ldt; };
__device__ __forceinline__ void tr8_load(float (&tv)[32], const TrJob& j, int lane) {
#pragma unroll
    for (int i = 0; i < 32; ++i) tv[i] = j.W[(size_t)(2 * i + (lane >> 5)) * j.ldw + (lane & 31)];
}
__device__ __forceinline__ void tr8_store(const float (&tv)[32], const TrJob& jb, float scale, LAS float* scr, int lane) {
#pragma unroll
    for (int i = 0; i < 32; ++i) scr[(2 * i + (lane >> 5)) * 33 + (lane & 31)] = tv[i] * scale;
    LDS_WAIT(); asm volatile("" ::: "memory");
    const int c = lane & 7;
#pragma unroll
    for (int j = 0; j < 4; ++j) { const int n = (lane >> 3) + 8 * j; const LAS float* s = scr + (8 * c) * 33 + n;
        u32x2 o; o.x = cvt4_fp8(s[0 * 33], s[1 * 33], s[2 * 33], s[3 * 33]); o.y = cvt4_fp8(s[4 * 33], s[5 * 33], s[6 * 33], s[7 * 33]);
        *(GAS u32x2*)(jb.WT + (size_t)n * jb.ldt + 8 * c) = o; }
    LDS_WAIT(); asm volatile("" ::: "memory");
}
__device__ __forceinline__ void tr_item8(const float* W, int ldw, int k0, int c0, unsigned char* WT, int ldt, int r0, float scale, LAS float* scr, int lane) {
    float tv[32];
#pragma unroll
    for (int i = 0; i < 32; ++i) tv[i] = W[(size_t)(k0 + 2 * i + (lane >> 5)) * ldw + c0 + (lane & 31)];
#pragma unroll
    for (int i = 0; i < 32; ++i) scr[(2 * i + (lane >> 5)) * 33 + (lane & 31)] = tv[i] * scale;
    LDS_WAIT(); asm volatile("" ::: "memory");
    const int c = lane & 7;
#pragma unroll
    for (int j = 0; j < 4; ++j) { const int n = (lane >> 3) + 8 * j; const LAS float* s = scr + (8 * c) * 33 + n;
        u32x2 o; o.x = cvt4_fp8(s[0 * 33], s[1 * 33], s[2 * 33], s[3 * 33]); o.y = cvt4_fp8(s[4 * 33], s[5 * 33], s[6 * 33], s[7 * 33]);
        *(GAS u32x2*)(WT + (size_t)(r0 + n) * ldt + k0 + 8 * c) = o; }
    LDS_WAIT(); asm volatile("" ::: "memory");
}

template <bool FP8 = false> __device__ __forceinline__ void row_norm_mod(f32x4 (&v)[4], const float* w, const float* sc, const float* sh, bf16* orow, int lane) {
    float ss = 0.f;
#pragma unroll
    for (int j = 0; j < 4; ++j) ss += (v[j].x * v[j].x + v[j].y * v[j].y) + (v[j].z * v[j].z + v[j].w * v[j].w);
    const float rstd = rsqrtf(wave_sum(ss) * (1.f / 1024.f) + EPS);
#pragma unroll
    for (int j = 0; j < 4; ++j) { const int c4 = lane + 64 * j; const f32x4 wv = ((const f32x4*)w)[c4], scv = ((const f32x4*)sc)[c4], shv = ((const f32x4*)sh)[c4];
        v[j] = v[j] * rstd * wv * (1.f + scv) + shv;
        if constexpr (FP8) { ((GAS unsigned*)orow)[c4] = cvt4_fp8_sat(v[j].x * MOE_AS, v[j].y * MOE_AS, v[j].z * MOE_AS, v[j].w * MOE_AS); }
        else { u32x2 o; o.x = cvt_pk_bf16(v[j].x, v[j].y); o.y = cvt_pk_bf16(v[j].z, v[j].w); ((GAS u32x2*)orow)[c4] = o; } }
}
__device__ __forceinline__ void load_row_f32(f32x4 (&v)[4], const float* row, int lane) {
#pragma unroll
    for (int j = 0; j < 4; ++j) v[j] = ((const GAS f32x4*)row)[lane + 64 * j];
}
__device__ __forceinline__ void load_row_bf16(f32x4 (&v)[4], const bf16* row, int lane) {
#pragma unroll
    for (int j = 0; j < 4; ++j) { const u32x2 w = ((const GAS u32x2*)row)[lane + 64 * j]; v[j] = (f32x4){bflo(w.x), bfhi(w.x), bflo(w.y), bfhi(w.y)}; }
}
__device__ __forceinline__ void store_row_bf16(const f32x4 (&v)[4], bf16* row, int lane) {
#pragma unroll
    for (int j = 0; j < 4; ++j) { u32x2 o; o.x = cvt_pk_bf16(v[j].x, v[j].y); o.y = cvt_pk_bf16(v[j].z, v[j].w); ((GAS u32x2*)row)[lane + 64 * j] = o; }
}
__device__ __forceinline__ void store_row_f32(const f32x4 (&v)[4], float* row, int lane) {
#pragma unroll
    for (int j = 0; j < 4; ++j) ((GAS f32x4*)row)[lane + 64 * j] = v[j];
}
__device__ __forceinline__ void row_post(f32x4 (&v)[4], const f32x4 (&base)[4], const float* w, const float* g, int lane) {
    float ss = 0.f;
#pragma unroll
    for (int j = 0; j < 4; ++j) ss += (v[j].x * v[j].x + v[j].y * v[j].y) + (v[j].z * v[j].z + v[j].w * v[j].w);
    const float rstd = rsqrtf(wave_sum(ss) * (1.f / 1024.f) + EPS);
#pragma unroll
    for (int j = 0; j < 4; ++j) { const int c4 = lane + 64 * j; const f32x4 wv = ((const f32x4*)w)[c4], gv = ((const f32x4*)g)[c4]; v[j] = base[j] + gv * (v[j] * rstd * wv); }
}

#define ROWMAP_DECL() const int WPB_ = C.NGW / NB, rb_ = C.gw / WPB_, wi_ = C.gw % WPB_
#define ROW_S(k) (wi_ + WPB_ * (k))
constexpr int PAR_OFF = 65536;
template <int NV, class F> __device__ __forceinline__ void stage_par(Ctx& C, int l, F f) {
    LAS float* P = (LAS float*)(C.lds + PAR_OFF); const int WPB_ = C.NGW / NB, rbf = (C.vcu * 8) / WPB_, rbl = (C.vcu * 8 + 7) / WPB_;
    __syncthreads();
    for (int i = C.tid; i < 3 * 1024; i += 512) { const int set = i >> 10, c = i & 1023, mb = set == 2 ? 16 : (set == 0 ? rbf : rbl);
        const float* md = WSP(float, WS_MODS) + ((size_t)l * 17 + mb) * 6144 + c; float o[NV]; f(md, c, o);
#pragma unroll
        for (int v = 0; v < NV; ++v) P[(set * NV + v) * 1024 + c] = o[v]; }
    __syncthreads();
}
#define PAR_SET(NV, sx) ((const LAS float*)(C.lds + PAR_OFF) + (((sx) < CT) ? 2 : (rb_ - (C.vcu * 8) / WPB_)) * (NV) * 1024)
__device__ __forceinline__ void row_post_l(f32x4 (&v)[4], const f32x4 (&base)[4], const LAS float* G, int lane) {
    float ss = 0.f;
#pragma unroll
    for (int j = 0; j < 4; ++j) ss += (v[j].x * v[j].x + v[j].y * v[j].y) + (v[j].z * v[j].z + v[j].w * v[j].w);
    const float rstd = rsqrtf(wave_sum(ss) * (1.f / 1024.f) + EPS);
#pragma unroll
    for (int j = 0; j < 4; ++j) { const f32x4 gv = ((const LAS f32x4*)G)[lane + 64 * j]; v[j] = base[j] + gv * (v[j] * rstd); }
}
template <bool FP8 = false> __device__ __forceinline__ void row_norm_l(f32x4 (&v)[4], const LAS float* A, const LAS float* B, bf16* orow, int lane) {
    float ss = 0.f;
#pragma unroll
    for (int j = 0; j < 4; ++j) ss += (v[j].x * v[j].x + v[j].y * v[j].y) + (v[j].z * v[j].z + v[j].w * v[j].w);
    const float rstd = rsqrtf(wave_sum(ss) * (1.f / 1024.f) + EPS);
#pragma unroll
    for (int j = 0; j < 4; ++j) { const int c4 = lane + 64 * j; const f32x4 av = ((const LAS f32x4*)A)[c4], bv = ((const LAS f32x4*)B)[c4];
        v[j] = v[j] * rstd * av + bv;
        if constexpr (FP8) { ((GAS unsigned*)orow)[c4] = cvt4_fp8_sat(v[j].x * MOE_AS, v[j].y * MOE_AS, v[j].z * MOE_AS, v[j].w * MOE_AS); }
        else { u32x2 o; o.x = cvt_pk_bf16(v[j].x, v[j].y); o.y = cvt_pk_bf16(v[j].z, v[j].w); ((GAS u32x2*)orow)[c4] = o; } }
}
struct Cplx { float r, i; };
__device__ __forceinline__ Cplx cmul(Cplx a, Cplx b) { return Cplx{a.r * b.r - a.i * b.i, a.r * b.i + a.i * b.r}; }
__device__ __forceinline__ Cplx cpow(Cplx a, int e) { Cplx r{1.f, 0.f};
#pragma unroll
    for (int bit = 0; bit < 7; ++bit) { if (e & (1 << bit)) r = cmul(r, a); a = cmul(a, a); }
    return r; }
__device__ __forceinline__ void s5_disc(const float* a_re, const float* a_im, const float* log_dt, int dgp  , Cplx& lam, Cplx& coef) {
    const float ar = a_re[dgp], ai = a_im[dgp], dt = __expf(log_dt[dgp >> 6]);
    const float mag = __expf(ar * dt); float rev = ai * dt * 0.15915494309189535f; rev -= rintf(rev);
    lam.r = mag * cosrev(rev); lam.i = mag * sinrev(rev);
    const float nr = lam.r - 1.f, ni = lam.i, den = ar * ar + ai * ai;
    coef.r = (nr * ar + ni * ai) / den; coef.i = (ni * ar - nr * ai) / den;
}

__device__ __forceinline__ void ph_pre_a(Ctx& C) {
    const float* c_in = C.in[1]; const float* cctx = C.in[3]; const float* ada_w = C.in[4]; const float* ada_b = C.in[5];
    if ((int)blockIdx.x < 192) {
        LAS float* sl = (LAS float*)C.lds;
        LAS float* red = (LAS float*)(C.lds + 17 * 1024 * 4);
        for (int i = C.tid; i < 17 * 1024; i += 512) { const float x = (i < 16384) ? c_in[i] : cctx[i - 16384]; sl[i] = fsilu(x); }
        __syncthreads();
        for (int it = blockIdx.x; it < 192; it += C.G) {
            const int l = it / 96, cb = it % 96, col = cb * 64 + (C.tid & 63), ks = C.tid >> 6;
            float acc[17];
#pragma unroll
            for (int b = 0; b < 17; ++b) acc[b] = 0.f;
            const float* wp = ada_w + (size_t)l * 1024 * 6144 + col;
#pragma unroll 8
            for (int k = ks * 128; k < ks * 128 + 128; ++k) { const float w = wp[(size_t)k * 6144];
#pragma unroll
                for (int b = 0; b < 17; ++b) acc[b] += sl[b * 1024 + k] * w; }
#pragma unroll
            for (int b = 0; b < 17; ++b) red[(ks * 17 + b) * 64 + (C.tid & 63)] = acc[b];
            __syncthreads();
            for (int i = C.tid; i < 17 * 64; i += 512) { const int b = i >> 6, cc = i & 63; float s = ada_b[l * 6144 + cb * 64 + cc];
#pragma unroll
                for (int k8 = 0; k8 < 8; ++k8) s += red[(k8 * 17 + b) * 64 + cc];
                WSP(float, WS_MODS)[((size_t)l * 17 + b) * 6144 + cb * 64 + cc] = s; }
            __syncthreads();
        }
    }
    { const bool spare = C.G >= 256; const int fi0 = spare ? (int)blockIdx.x - 192 : (int)blockIdx.x, fst = spare ? C.G - 192 : C.G;
      if (fi0 >= 0) {
    for (int it = fi0; it < 2 * 128; it += fst) {
        const int l = it >> 7, kc = it & 127, p = C.tid; const float* wi = C.in[10] + (size_t)l * 1024 * 2048 + (size_t)(kc * 8) * 2048 + 1536;
        LAS float* wl = (LAS float*)C.lds;
        LAS float* tab = wl + 2048;
        __syncthreads();
        for (int i = C.tid; i < 2048; i += 512) wl[i] = wi[(size_t)(i >> 8) * 2048 + (i & 255)];
        if (C.tid < 64) tab[C.tid] = cosrev((float)C.tid * (1.f / 64.f));
        __syncthreads();
        int cs, ch; ft_row(p, cs, ch); const int g = ch >> 6, j = ch & 63, sh = cs ? 16 : 0;
        float acc[8];
#pragma unroll
        for (int e = 0; e < 8; ++e) acc[e] = 0.f;
#pragma unroll 4
        for (int c = 0; c < 64; ++c) { const float w = tab[(j * c - sh) & 63];
#pragma unroll
            for (int e = 0; e < 8; ++e) acc[e] += wl[e * 256 + g * 64 + c] * w; }
        u32x4 o; o.x = cvt_pk_bf16(acc[0] * 0.125f, acc[1] * 0.125f); o.y = cvt_pk_bf16(acc[2] * 0.125f, acc[3] * 0.125f); o.z = cvt_pk_bf16(acc[4] * 0.125f, acc[5] * 0.125f); o.w = cvt_pk_bf16(acc[6] * 0.125f, acc[7] * 0.125f);
        *(GAS u32x4*)(WSP(bf16, WS_WIN) + ((size_t)l * NWIN + 1792 + p) * 1024 + kc * 8) = o;
    }
    for (int it = fi0; it < 2 * 128; it += fst) {
        const int l = it >> 7, nc = (it >> 3) & 15, rc = it & 7;
        LAS float* WO = (LAS float*)C.lds;
        LAS float* FW = WO + 16384;
        const float* wo = C.in[11] + (size_t)l * 1048576 + (size_t)512 * 1024 + nc * 64; const float* fw = C.in[17] + (size_t)l * 65536 + (size_t)(rc * 32) * 256;
        __syncthreads();
#pragma unroll
        for (int i = 0; i < 8; ++i) { const int idx = C.tid + i * 512, j = idx >> 4, n4 = (idx & 15) * 4; *(LAS f32x4*)(WO + j * 64 + n4) = *(const GAS f32x4*)(wo + (size_t)j * 1024 + n4); }
#pragma unroll
        for (int i = 0; i < 4; ++i) { const int idx = C.tid + i * 512; *(LAS f32x4*)(FW + idx * 4) = *(const GAS f32x4*)(fw + (size_t)idx * 4); }
        __syncthreads();
        const int n = C.tid & 63, rq = C.wave; float acc[4] = {0.f, 0.f, 0.f, 0.f};
#pragma unroll 2
        for (int j = 0; j < 256; j += 4) { const float w0 = WO[j * 64 + n], w1 = WO[(j + 1) * 64 + n], w2 = WO[(j + 2) * 64 + n], w3 = WO[(j + 3) * 64 + n];
#pragma unroll
            for (int e = 0; e < 4; ++e) { const f32x4 f = *(const LAS f32x4*)(FW + (rq * 4 + e) * 256 + j); acc[e] += (f[0] * w0 + f[1] * w1) + (f[2] * w2 + f[3] * w3); } }
        u32x2 o; o.x = cvt_pk_bf16(acc[0], acc[1]); o.y = cvt_pk_bf16(acc[2], acc[3]);
        *(GAS u32x2*)(WSP(bf16, WS_WOUT) + (size_t)l * 1048576 + (size_t)(nc * 64 + n) * 1024 + 512 + rc * 32 + rq * 4) = o;
    }
    __syncthreads();
      } }
    __syncthreads();
    {
        LAS float* scr = (LAS float*)(C.lds + C.wave * 16384);
        constexpr int I_WIN = 16 * 56, I_WOUT = 16 * 32, I_GLU = 4 * 8, I_L = I_WIN + I_WOUT + I_GLU, I_G = 16 * 88, I_D = 44 * 32, NIT = 2 * I_L + 2 * I_G + I_D;
        for (int it = C.gw; it < NIT; it += C.NGW) {
            int r = it;
            if (r < 2 * I_L) { const int l = r / I_L; r %= I_L;
                if (r < I_WIN) { const int kb = r / 56, nb = r % 56; const int c0 = nb < 48 ? nb * 32 : 1792 + (nb - 48) * 32;
                    tr_item(C.in[10] + (size_t)l * 1024 * 2048, 2048, kb * 64, c0, WSP(bf16, WS_WIN) + (size_t)l * NWIN * 1024, 1024, nb * 32, nb < 32, scr, C.lane); continue; }
                r -= I_WIN;
                if (r < I_WOUT) { const int kb = r / 32, nb = r % 32; if (kb >= 8 && kb < 12) continue;
                    tr_item(C.in[11] + (size_t)l * 1024 * 1024, 1024, kb * 64, nb * 32, WSP(bf16, WS_WOUT) + (size_t)l * 1024 * 1024, 1024, nb * 32, 0, scr, C.lane); continue; }
                r -= I_WOUT;
                { const int kb = r / 8, nb = r % 8; tr_item(C.in[26] + (size_t)l * 65536, 256, kb * 64, nb * 32, WSP(bf16, WS_GLU) + (size_t)l * 65536, 256, nb * 32, 0, scr, C.lane); continue; }
            }
            r -= 2 * I_L;
            if (r < 2 * I_G) { const int up = r / I_G; r %= I_G; const int kb = r / 88, nb = r % 88;
                tr_item8(C.in[27 + up], FD, kb * 64, nb * 32, C.ws + WS_WGU, 1024, (nb >> 2) * 256 + up * 128 + (nb & 3) * 32, MOE_WS, scr, C.lane); continue; }
            r -= 2 * I_G;
            { const int kb = r / 32, nb = r % 32; tr_item(C.in[29], 1024, kb * 64, nb * 32, WSP(bf16, WS_WD), FD, nb * 32, 0, scr, C.lane); }
        }
    }
    const int gt = C.vcu * 512 + C.tid, NGT = C.G * 512;
    for (int it = gt; it < 256 * 64; it += NGT) { const int k = it >> 6, t0 = (it & 63) * 8; float v[8];
#pragma unroll
        for (int e = 0; e < 8; ++e) { const int tp = t0 + e, t = tp & 255; const float rev = (float)((k * t) & 255) * (1.f / 256.f); v[e] = (tp < 256 ? cosrev(rev) : -sinrev(rev)) * 0.0625f; }
        u32x4 o; o.x = cvt_pk_bf16(v[0], v[1]); o.y = cvt_pk_bf16(v[2], v[3]); o.z = cvt_pk_bf16(v[4], v[5]); o.w = cvt_pk_bf16(v[6], v[7]);
        *(GAS u32x4*)(WSP(bf16, WS_DFTC) + (size_t)k * 512 + t0) = o; }
    for (int it = gt; it < 2 * 2048; it += NGT) { const int l = it >> 11, dgp = it & 2047; Cplx lam, coef; s5_disc(C.in[18] + l * 2048, C.in[19] + l * 2048, C.in[20] + l * 32, dgp, lam, coef);
        f32x2* pw = WSP(f32x2, WS_S5POW) + (size_t)it * 66; Cplx a{1.f, 0.f};
        f32x2* pt = WSP(f32x2, WS_S5POWT) + ((size_t)(l * 32 + (dgp >> 6)) * 65) * 64 + (dgp & 63);
        for (int e = 0; e <= 64; ++e) { pw[e] = (f32x2){a.r, a.i}; pt[(size_t)e * 64] = (f32x2){a.r, a.i}; a = cmul(a, lam); }
        pw[65] = (f32x2){coef.r, coef.i}; }
    for (int it = gt; it < 1024; it += NGT) { const int pos = it >> 4, i = it & 15; const float inv = exp2f(-(float)i * (13.287712379549449f / 16.f)); float rev = (float)pos * inv * 0.15915494309189535f; rev -= floorf(rev);
        WSP(float, WS_ROPE)[2 * it] = cosrev(rev); WSP(float, WS_ROPE)[2 * it + 1] = sinrev(rev); }
}

__device__ __forceinline__ void s5_build(Ctx& C, int l, int mask = 7) {
    const float* a_re = C.in[18] + l * 2048; const float* a_im = C.in[19] + l * 2048; const float* log_dt = C.in[20] + l * 32;
    const float* b_re = C.in[21] + (size_t)l * 32768; const float* b_im = C.in[22] + (size_t)l * 32768;
    const float* c_re = C.in[23] + (size_t)l * 32768; const float* c_im = C.in[24] + (size_t)l * 32768;
    bf16* KIN = WSP(bf16, WS_KIN); bf16* KTOT = WSP(bf16, WS_KTOT);
    const int gt = C.vcu * 512 + C.tid, NGT = C.G * 512;
    if (mask & 1) for (int it = gt; it < 16 * 256 * CHT; it += NGT) {
        const int g = it >> 12, n = (it >> 4) & 255, sx = it & 15, dir = n >> 7, reim = (n >> 6) & 1, p = n & 63, dgp = (dir * 16 + g) * 64 + p;
        const f32x2* pw = WSP(f32x2, WS_S5POW) + ((size_t)l * 2048 + dgp) * 66; const f32x2 pe = pw[dir ? sx : CHT - 1 - sx], pc = pw[65]; const Cplx P = cmul(Cplx{pe.x, pe.y}, Cplx{pc.x, pc.y});
        const float* br = b_re + (size_t)dgp * 16; const float* bi = b_im + (size_t)dgp * 16; float v[16];
#pragma unroll
        for (int ch = 0; ch < 16; ++ch) { const Cplx x = cmul(P, Cplx{br[ch], bi[ch]}); v[ch] = reim ? x.i : x.r; }
        u32x4 o0, o1; o0.x = cvt_pk_bf16(v[0], v[1]); o0.y = cvt_pk_bf16(v[2], v[3]); o0.z = cvt_pk_bf16(v[4], v[5]); o0.w = cvt_pk_bf16(v[6], v[7]);
        o1.x = cvt_pk_bf16(v[8], v[9]); o1.y = cvt_pk_bf16(v[10], v[11]); o1.z = cvt_pk_bf16(v[12], v[13]); o1.w = cvt_pk_bf16(v[14], v[15]);
        GAS u32x4* dst = (GAS u32x4*)(KIN + ((size_t)g * 256 + n) * S5K1 + sx * 16); dst[0] = o0; dst[1] = o1;
    }
    if (mask & 2) for (int it0 = gt; it0 < 16 * 256 * 256; it0 += 4 * NGT) {
        f32x2 pe[4]; float cr[4], cim[4];
#pragma unroll
        for (int q = 0; q < 4; ++q) { const int it = it0 + q * NGT; if (it < 16 * 256 * 256) {
            const int g = it >> 16, n2 = (it >> 8) & 255, n = it & 255, t = n2 >> 4, ch = n2 & 15, dir = n >> 7, p = n & 63;
            pe[q] = WSP(f32x2, WS_S5POWT)[((size_t)(l * 32 + dir * 16 + g) * 65 + (dir ? CHT - t : t + 1)) * 64 + p];
            const size_t ci = ((size_t)(dir * 16 + g) * 16 + ch) * 64 + p; cr[q] = c_re[ci]; cim[q] = c_im[ci]; } }
#pragma unroll
        for (int q = 0; q < 4; ++q) { const int it = it0 + q * NGT; if (it < 16 * 256 * 256) {
            const int g = it >> 16, n2 = (it >> 8) & 255, n = it & 255, reim = (n >> 6) & 1;
            const Cplx W = cmul(Cplx{cr[q], cim[q]}, Cplx{pe[q].x, pe[q].y});
            KTOT[((size_t)g * 256 + n2) * S5K2 + S5K1 + n] = (bf16)(cvt_pk_bf16(reim ? -W.i : W.r, 0.f) & 0xffffu); } }
    }
    if (mask & 4) {
        constexpr int TB = 1;
        LAS float* LP = (LAS float*)C.lds;
        LAS float* KT = LP + TB * 256;
        LAS float* CR = KT + TB * 512;
        LAS float* CI = CR + 2048; LAS float* BR = CI + 2048; LAS float* BI = BR + 2048;
        constexpr int nb = 16 * CHT / TB;
        int gl = -1;
        for (int bt = C.vcu; bt < nb; bt += C.G) {
            const int g = (bt * TB) / CHT, tau0 = (bt * TB) % CHT;
            __syncthreads();
            if (g != gl) { for (int i = C.tid; i < 2048; i += 512) { const int dir = i >> 10, r = i & 1023; const size_t o = (size_t)(dir * 16 + g) * 1024 + r; CR[i] = c_re[o]; CI[i] = c_im[o]; BR[i] = b_re[o]; BI[i] = b_im[o]; } gl = g; }
            if (C.tid < TB * 128) { const int tb = C.tid >> 7, dir = (C.tid >> 6) & 1, p = C.tid & 63; const f32x2* pw = WSP(f32x2, WS_S5POW) + ((size_t)l * 2048 + (dir * 16 + g) * 64 + p) * 66; const f32x2 pe = pw[tau0 + tb], pc = pw[65];
              const Cplx P = cmul(Cplx{pe.x, pe.y}, Cplx{pc.x, pc.y}); LP[2 * C.tid] = P.r; LP[2 * C.tid + 1] = P.i; }
            __syncthreads();
            { const int dir = C.tid >> 8, ch = (C.tid >> 4) & 15, cp = C.tid & 15; float sacc[TB];
#pragma unroll
              for (int tb = 0; tb < TB; ++tb) sacc[tb] = 0.f;
#pragma unroll 4
              for (int p = 0; p < 64; ++p) { const int ci = dir * 1024 + ch * 64 + p, bi_ = dir * 1024 + p * 16 + cp; const Cplx cb = cmul(Cplx{CR[ci], CI[ci]}, Cplx{BR[bi_], BI[bi_]});
#pragma unroll
                  for (int tb = 0; tb < TB; ++tb) { const int li = 2 * (tb * 128 + dir * 64 + p); sacc[tb] += cb.r * LP[li] - cb.i * LP[li + 1]; } }
#pragma unroll
              for (int tb = 0; tb < TB; ++tb) KT[tb * 512 + C.tid] = sacc[tb]; }
            __syncthreads();
#pragma unroll
            for (int tb = 0; tb < TB; ++tb) { const int tau = tau0 + tb, nblk = CHT - tau; const LAS float* kt = KT + tb * 512;
                for (int w = C.tid; w < 2 * nblk * 32; w += 512) {
                    const int dir = w >= nblk * 32, r = dir ? w - nblk * 32 : w, blk = r >> 5, ch = (r >> 1) & 15, half = r & 1;
                    if (tau == 0 && dir == 1) continue;
                    const int t = dir ? blk : blk + tau, sx = dir ? blk + tau : blk; float v[8];
#pragma unroll
                    for (int e = 0; e < 8; ++e) { v[e] = kt[dir * 256 + ch * 16 + half * 8 + e]; if (tau == 0) v[e] += kt[256 + ch * 16 + half * 8 + e]; }
                    u32x4 o; o.x = cvt_pk_bf16(v[0], v[1]); o.y = cvt_pk_bf16(v[2], v[3]); o.z = cvt_pk_bf16(v[4], v[5]); o.w = cvt_pk_bf16(v[6], v[7]);
                    *(GAS u32x4*)(KTOT + ((size_t)g * 256 + t * 16 + ch) * S5K2 + sx * 16 + half * 8) = o;
                } }
        }
        __syncthreads();
    }
}

__device__ __forceinline__ const float* xrow_in(Ctx& C, int r) { const int b = r / SA, s = r % SA; return s < CT ? C.in[2] + ((size_t)b * CT + s) * 1024 : C.in[0] + ((size_t)b * SQ + (s - CT)) * 1024; }
__device__ __forceinline__ bf16* xbrow(Ctx& C, int r) { const int b = r / SA, s = r % SA; return s < CT ? WSP(bf16, WS_X1C) + ((size_t)b * CT + s) * 1024 : (bf16*)C.out + ((size_t)b * SQ + (s - CT)) * 1024; }
__device__ __forceinline__ float* xrow_cur(Ctx& C, int r) { const int b = r / SA, s = r % SA; return s < CT ? WSP(float, WS_X1C) + ((size_t)b * CT + s) * 1024 : C.out + ((size_t)b * SQ + (s - CT)) * 1024; }
__device__ __forceinline__ const float* modp(Ctx& C, int l, int r, int chunk) { const int b = r / SA, s = r % SA; return WSP(float, WS_MODS) + ((size_t)l * 17 + (s < CT ? 16 : b)) * 6144 + chunk * 1024; }

__device__ __forceinline__ void ph_pre_b(Ctx& C) {
    const int gt = C.vcu * 512 + C.tid, NGT = C.G * 512;
    { const float* w1 = C.in[6];
      stage_par<2>(C, 0, [&](const float* md, int c, float (&o)[2]) { o[0] = w1[c] * (1.f + md[1024]); o[1] = md[0]; }); }
    { constexpr int NR = 6; ROWMAP_DECL();
      for (int k0 = 0; ROW_S(k0) < SA; k0 += NR) { f32x4 v[NR][4];
#pragma unroll
        for (int q = 0; q < NR; ++q) { const int sx = ROW_S(k0 + q), r = rb_ * SA + sx; if (sx < SA) load_row_f32(v[q], xrow_in(C, r), C.lane); }
#pragma unroll
        for (int q = 0; q < NR; ++q) { const int sx = ROW_S(k0 + q), r = rb_ * SA + sx; if (sx < SA) { const LAS float* Ps = PAR_SET(2, sx); row_norm_l(v[q], Ps, Ps + 1024, WSP(bf16, WS_HN) + (size_t)r * 1024, C.lane); } } } }
    s5_build(C, 0);
}

__device__ __forceinline__ void ph_win(Ctx& C, int l) {
    {
        pg8::Gemm g{WSP(bf16, WS_HN), WSP(bf16, WS_WIN) + (size_t)l * NWIN * 1024}; typedef pg8::Shape<1024, 1024, 1024> Sh;
        constexpr int ROPE_LDS = RING_BYTES + 2048;
        { LAS float* rl = (LAS float*)(C.lds + ROPE_LDS); for (int i = C.tid; i < 2048; i += 512) rl[i] = WSP(float, WS_ROPE)[i]; __syncthreads(); }
        EpiIn E{C.ws, (const LAS float*)(C.lds + ROPE_LDS)};
        if (l == 0) { ListOrder<Dec2D> S{144 * 7, C.G, (int)blockIdx.x, Dec2D{144, 7, 0, 0}}; pg8::gemm_phase<Sh>(C.lds, g, S, E); }
        else { ListOrder<DecWin1> S{976, C.G, (int)blockIdx.x, DecWin1{}}; pg8::gemm_phase<Sh>(C.lds, g, S, E); }
    }
    RELAUNDER();
    {
        pg8::Gemm g{WSP(bf16, WS_WIN) + ((size_t)l * NWIN + 1792) * 1024, WSP(bf16, WS_HN)}; typedef pg8::Shape<1024, 1024, 1024> Sh;
        EpiFT E{C.ws};
        if (l == 0) { ListOrder<DecFT0> S{160, C.G, (int)blockIdx.x, DecFT0{}}; pg8::gemm_phase<Sh>(C.lds, g, S, E); }
        else { ListOrder<Dec2D> S{128, C.G, (int)blockIdx.x, Dec2D{1, 128, 0, 1}}; pg8::gemm_phase<Sh>(C.lds, g, S, E); }
    }
}

__device__ __forceinline__ void attn_dispatch(Ctx& C, int u, bool fuse = false, float lamv = 0.f, float oml = 0.f, const float* sub = nullptr) {
    const bf16* Q = WSP(bf16, WS_Q); const bf16* K = WSP(bf16, WS_K); const bf16* V = WSP(bf16, WS_V); bf16* AO = WSP(bf16, WS_AO);
    int b, h, map, qrow, seq;
    if (u < 1024) { const int qb = u & 7; map = (u >> 3) & 1; h = (u >> 4) & 3; b = u >> 6; qrow = b * SA + CT + qb * 256; seq = SA; }
    else { const int uc = u - 1024; map = uc & 1; h = (uc >> 1) & 3; b = uc >> 3; qrow = b * SA; seq = CT; }
    const int hm = (h * 2 + map) * 64;
    if (fuse) att::attn_unit<true>(Q + (size_t)qrow * 512 + hm, K + (size_t)(b * SA) * 512 + hm, V + (size_t)(b * SA) * 512 + h * 128, AO + (size_t)qrow * 1024 + (h * 2 + map) * 128, seq, C.ldsg,
                                   WSP(bf16, WS_CAT) + (size_t)qrow * 1024 + h * 128, lamv, oml, sub);
    else att::attn_unit<false>(Q + (size_t)qrow * 512 + hm, K + (size_t)(b * SA) * 512 + hm, V + (size_t)(b * SA) * 512 + h * 128, AO + (size_t)qrow * 1024 + (h * 2 + map) * 128, seq, C.ldsg);
}

#define FSW(p) ((p) ^ ((((p) >> 5) & 3) * 10))
template <int H> __device__ __forceinline__ void fft_pass4(LAS f32x2* X, int tid) {
    constexpr int LH = H == 2 ? 1 : H == 8 ? 3 : H == 32 ? 5 : H == 128 ? 7 : 9;
    { const int g = tid, j = g >> LH, k = g & (H - 1), p0 = (j << (LH + 2)) + k;
        const float rev = (float)k * (1.f / (float)(4 * H)); const float c1 = cosrev(rev), s1 = -sinrev(rev); const float c2 = c1 * c1 - s1 * s1, s2 = 2.f * c1 * s1;
        const int i0 = FSW(p0), i1 = FSW(p0 + H), i2 = FSW(p0 + 2 * H), i3 = FSW(p0 + 3 * H);
#pragma unroll 3
        for (int q = 0; q < 9; ++q) { LAS f32x2* S = X + q * 2048;
        const f32x2 x0 = S[i0], x1 = S[i1], x2 = S[i2], x3 = S[i3];
        const f32x2 t1 = (f32x2){x1.x * c2 - x1.y * s2, x1.x * s2 + x1.y * c2}, t3 = (f32x2){x3.x * c2 - x3.y * s2, x3.x * s2 + x3.y * c2};
        const f32x2 a0 = x0 + t1, a1 = x0 - t1, a2 = x2 + t3, a3 = x2 - t3;
        const f32x2 b2 = (f32x2){a2.x * c1 - a2.y * s1, a2.x * s1 + a2.y * c1};
        const f32x2 m3 = (f32x2){a3.x * c1 - a3.y * s1, a3.x * s1 + a3.y * c1};
        const f32x2 b3 = (f32x2){m3.y, -m3.x};
        S[i0] = a0 + b2; S[i2] = a0 - b2; S[i1] = a1 + b3; S[i3] = a1 - b3; } }
    __syncthreads();
}
__device__ __forceinline__ void fft_item(Ctx& C, int it) {
    const int b = it >> 4, g = (it >> 2) & 3, m = it & 3;
    LAS f32x2* X = (LAS f32x2*)C.lds;
    const bf16* src = WSP(bf16, WS_FT2) + (size_t)(b * 256 + g * 64 + m * 8) * 4096;
    __syncthreads();
    for (int i2 = C.tid; i2 < 9 * 128; i2 += 512) { const int q = i2 >> 7, t0 = (i2 & 127) * 8, j = m * 8 + q; const bf16* sq = src + (size_t)q * 4096 + t0;
        const u32x4 gc0 = *(const GAS u32x4*)sq, gc1 = *(const GAS u32x4*)(sq + 1024); u32x4 gs0 = (u32x4){0u, 0u, 0u, 0u}, gs1 = gs0;
        if ((j & 31) != 0) { gs0 = *(const GAS u32x4*)(sq + 2048); gs1 = *(const GAS u32x4*)(sq + 3072); }
        const unsigned c0[4] = {gc0.x, gc0.y, gc0.z, gc0.w}, c1[4] = {gc1.x, gc1.y, gc1.z, gc1.w}, s0[4] = {gs0.x, gs0.y, gs0.z, gs0.w}, s1[4] = {gs1.x, gs1.y, gs1.z, gs1.w};
#pragma unroll
        for (int e = 0; e < 8; ++e) { const int w = e >> 1; const bool hi = e & 1;
            const f32x2 u = (f32x2){hi ? bfhi(c0[w]) : bflo(c0[w]), -(hi ? bfhi(s0[w]) : bflo(s0[w]))}, v = (f32x2){hi ? bfhi(c1[w]) : bflo(c1[w]), -(hi ? bfhi(s1[w]) : bflo(s1[w]))};
            const int p = (int)(__brev((unsigned)(t0 + e)) >> 21);
            X[q * 2048 + FSW(p)] = u + v; X[q * 2048 + FSW(p + 1)] = u - v; } }
    __syncthreads();
    fft_pass4<2>(X, C.tid); fft_pass4<8>(X, C.tid); fft_pass4<32>(X, C.tid); fft_pass4<128>(X, C.tid); fft_pass4<512>(X, C.tid);
    bf16* dst = WSP(bf16, WS_CAT) + (size_t)(b * SA + CT) * 1024 + 512 + g * 64;
    for (int k = C.tid; k < 2048; k += 512) { float v[8], w[8]; const int kd = FSW(k), km = FSW((2048 - k) & 2047);
#pragma unroll
        for (int q = 0; q < 8; ++q) { v[q] = X[q * 2048 + kd].x * 0.02209708691207961f; w[q] = X[(8 - q) * 2048 + km].x * 0.02209708691207961f; }
        u32x4 o; o.x = cvt_pk_bf16(v[0], v[1]); o.y = cvt_pk_bf16(v[2], v[3]); o.z = cvt_pk_bf16(v[4], v[5]); o.w = cvt_pk_bf16(v[6], v[7]);
        *(GAS u32x4*)(dst + (size_t)k * 1024 + m * 8) = o;
        o.x = cvt_pk_bf16(w[0], w[1]); o.y = cvt_pk_bf16(w[2], w[3]); o.z = cvt_pk_bf16(w[4], w[5]); o.w = cvt_pk_bf16(w[6], w[7]);
        *(GAS u32x4*)(dst + (size_t)k * 1024 + 56 - m * 8) = o; }
    __syncthreads();
    if (C.tid == 0) { volatile LAS unsigned* st = (volatile LAS unsigned*)(C.lds + MISC_OFF) + 8; st[0] = 0u; st[1] = 0u; }
}
__device__ __forceinline__ void ph_mix(Ctx& C, int l) {
    {
        const float li = l == 0 ? 0.2f : 0.35550906759559083f; const float d1 = C.in[12][l * 64 + C.lane] * C.in[13][l * 64 + C.lane], d2 = C.in[14][l * 64 + C.lane] * C.in[15][l * 64 + C.lane];
        const float lamv = __expf(wave_sum(d1)) - __expf(wave_sum(d2)) + li; const float* sub = C.in[16] + l * 128;
        for (int P = C.vcu; P < 512; P += C.G) { const int u0 = ((P >> 5) << 6) | (((P >> 3) & 3) << 4) | (P & 7);
            attn_dispatch(C, u0); attn_dispatch(C, u0 | 8, true, lamv, 1.f - li, sub); }
        if (l == 0) for (int u = 1024 + C.vcu; u < 1152; u += C.G) attn_dispatch(C, u);
    }
    for (int it = C.G - 1 - C.vcu; it < 16 * 16; it += C.G) fft_item(C, it);
    RELAUNDER();
    if (l == 0) {
        pg8::Gemm g{WSP(bf16, WS_DFTC), WSP(bf16, WS_FTC)}; typedef pg8::Shape<512, 512, 512> Sh;
        ListOrder<Dec2D> S{16, C.G, C.vcu, Dec2D{1, 16, 0, 0}};
        EpiDft E{C.ws, 0};
        pg8::gemm_phase<Sh>(C.lds, g, S, E);
    }
    RELAUNDER();
    {
        pg8::Gemm g{WSP(bf16, WS_UA), WSP(bf16, WS_KIN)}; typedef pg8::Shape<S5K2, S5K1, S5K1, (long)S5ROWS * S5K2, 256L * S5K1> Sh;
        ListOrder<DecBatch> S{16 * 9, C.G, C.G - 1 - C.vcu, DecBatch{9, 1}};
        EpiF32z<WS_HLOC, 256, (long)S5ROWS * 256> E{C.ws};
        pg8::gemm_phase<Sh>(C.lds, g, S, E);
    }
}

__device__ __forceinline__ void ph_carry(Ctx& C, int l) {
    for (int cg = C.vcu; cg < 16 * 16 * 2; cg += C.G) {
        const int seg = C.wave, g = cg >> 5, b = (cg >> 1) & 15, dir = cg & 1, p = C.lane;
        const f32x2 pT = WSP(f32x2, WS_S5POW)[((size_t)l * 2048 + (dir * 16 + g) * 64 + p) * 66 + CHT]; const Cplx LT{pT.x, pT.y};
        const float* hl = WSP(float, WS_HLOC) + ((size_t)g * S5ROWS + b * NCH) * 256 + dir * 128 + p; bf16* ua = WSP(bf16, WS_UA) + ((size_t)g * S5ROWS + b * NCH) * S5K2 + S5K1 + dir * 128 + p;
        constexpr int CB = 18, NCC = CT / CHT;
        static_assert(NCH == 8 * CB, "eight segments per chain");
        LAS f32x2* EL = (LAS f32x2*)C.lds;
        float xr[CB], xi[CB];
#pragma unroll
        for (int j = 0; j < CB; ++j) { const int i = seg * CB + j, c = dir ? (i < NCC ? NCC - 1 - i : NCH + NCC - 1 - i) : i; xr[j] = hl[(size_t)c * 256]; xi[j] = hl[(size_t)c * 256 + 64]; }
        Cplx e{0.f, 0.f};
#pragma unroll
        for (int j = 0; j < CB; ++j) { e = cmul(LT, e); e.r += xr[j]; e.i += xi[j]; }
        __syncthreads();
        EL[seg * 64 + p] = (f32x2){e.r, e.i};
        __syncthreads();
        const Cplx Lp = cpow(LT, CB); Cplx h{0.f, 0.f};
        for (int t = 0; t < seg; ++t) { const f32x2 et = EL[t * 64 + p]; h = cmul(Lp, h); h.r += et.x; h.i += et.y; }
#pragma unroll
        for (int j = 0; j < CB; ++j) { const int i = seg * CB + j, c = dir ? (i < NCC ? NCC - 1 - i : NCH + NCC - 1 - i) : i;
            ua[(size_t)c * S5K2] = (bf16)(cvt_pk_bf16(h.r, 0.f) & 0xffffu); ua[(size_t)c * S5K2 + 64] = (bf16)(cvt_pk_bf16(h.i, 0.f) & 0xffffu); h = cmul(LT, h); h.r += xr[j]; h.i += xi[j]; }
    }
    constexpr int NCW = 0;
    {
        const float li = l == 0 ? 0.2f : 0.35550906759559083f; float d1 = C.in[12][l * 64 + C.lane] * C.in[13][l * 64 + C.lane], d2 = C.in[14][l * 64 + C.lane] * C.in[15][l * 64 + C.lane];
        const float lamv = __expf(wave_sum(d1)) - __expf(wave_sum(d2)) + li; const float* sub = C.in[16] + l * 128; const bf16* AO = WSP(bf16, WS_AO); bf16* CAT = WSP(bf16, WS_CAT);
        const int hh = C.lane >> 4, d8 = (C.lane & 15) * 8; f32x4 s0 = *(const f32x4*)(sub + d8), s1 = *(const f32x4*)(sub + d8 + 4);
        constexpr int NR = 6; const int fgw = C.gw - NCW * 8, FNGW = C.NGW - NCW * 8;
        if (fgw >= 0 && l == 0) for (int i0 = fgw; i0 < NB * CT; i0 += NR * FNGW) { u32x4 aa[NR], bb[NR]; bool ok[NR];
#pragma unroll
            for (int q = 0; q < NR; ++q) { const int iq = i0 + q * FNGW, r = (iq / CT) * SA + (iq % CT); ok[q] = iq < NB * CT;
                if (ok[q]) { aa[q] = *(const GAS u32x4*)(AO + (size_t)r * 1024 + hh * 256 + d8); bb[q] = *(const GAS u32x4*)(AO + (size_t)r * 1024 + hh * 256 + 128 + d8); } }
#pragma unroll
            for (int q = 0; q < NR; ++q) { if (!ok[q]) continue; const int iq = i0 + q * FNGW, r = (iq / CT) * SA + (iq % CT); const u32x4 a = aa[q], bq = bb[q]; float v[8];
            v[0] = bflo(a.x) - lamv * bflo(bq.x); v[1] = bfhi(a.x) - lamv * bfhi(bq.x); v[2] = bflo(a.y) - lamv * bflo(bq.y); v[3] = bfhi(a.y) - lamv * bfhi(bq.y);
            v[4] = bflo(a.z) - lamv * bflo(bq.z); v[5] = bfhi(a.z) - lamv * bfhi(bq.z); v[6] = bflo(a.w) - lamv * bflo(bq.w); v[7] = bfhi(a.w) - lamv * bfhi(bq.w);
            float ss = 0.f;
#pragma unroll
            for (int e = 0; e < 8; ++e) ss += v[e] * v[e];
#pragma unroll
            for (int o = 1; o < 16; o <<= 1) ss += __shfl_xor(ss, o);
            const float sc = rsqrtf(ss * (1.f / 128.f) + EPS) * (1.f - li);
            u32x4 o; o.x = cvt_pk_bf16(v[0] * sc * s0[0], v[1] * sc * s0[1]); o.y = cvt_pk_bf16(v[2] * sc * s0[2], v[3] * sc * s0[3]); o.z = cvt_pk_bf16(v[4] * sc * s1[0], v[5] * sc * s1[1]); o.w = cvt_pk_bf16(v[6] * sc * s1[2], v[7] * sc * s1[3]);
            *(GAS u32x4*)(CAT + (size_t)r * 1024 + hh * 128 + d8) = o; } }
    }
}

__device__ __forceinline__ void ph_s5g2(Ctx& C, int l) {
    pg8::Gemm g{WSP(bf16, WS_UA), WSP(bf16, WS_KTOT)}; typedef pg8::Shape<S5K2, S5K2, S5K2, (long)S5ROWS * S5K2, 256L * S5K2> Sh;
    ListOrder<DecBatch> S{16 * 9, C.G, (int)blockIdx.x, DecBatch{9, 1}};
    EpiS5 E{C.ws, C.in[25] + l * 256, l == 1};
    pg8::gemm_phase<Sh>(C.lds, g, S, E);
}
__device__ __forceinline__ void ph_glu(Ctx& C, int l) {
    pg8::Gemm g{WSP(bf16, WS_YY), WSP(bf16, WS_GLU) + (size_t)l * 65536}; typedef pg8::Shape<256, 256, 256> Sh;
    const int nM = l == 0 ? 144 : 128;
    ListOrder<Dec2D> S{nM, C.G, (int)blockIdx.x, Dec2D{nM, 1, l == 0 ? 0 : 1, 0}};
    EpiGlu E{C.ws};
    pg8::gemm_phase<Sh>(C.lds, g, S, E);
}
__device__ __forceinline__ void ph_wout(Ctx& C, int l) {
    pg8::Gemm g{WSP(bf16, WS_CAT), WSP(bf16, WS_WOUT) + (size_t)l * 1024 * 1024}; typedef pg8::Shape<1024, 1024, 1024> Sh;
    { ListOrder<Dec2D> S{128 * 4, C.G, (int)blockIdx.x, Dec2D{128, 4, 1, 0}};
      EpiPlain<WS_HN, 1024> E{C.ws};
      pg8::gemm_phase<Sh>(C.lds, g, S, E); }
    if (l == 0) {
        RELAUNDER();
        pg8::Gemm g2{WSP(bf16, WS_CAT), WSP(bf16, WS_WOUT)}; typedef pg8::Shape<1024, 1024, 256, 256, 256> Sh2;
        ListOrder<DecCtxK4> S{256, C.G, (int)blockIdx.x, DecCtxK4{}};
        EpiCtxPart E{C.ws, 0};
        pg8::gemm_phase<Sh2>(C.lds, g2, S, E);
    }
}

template <int l> __device__ __forceinline__ void ph_norm2(Ctx& C) {
    unsigned char* H2 = C.ws + (l == 0 ? WS_H2_L0 : WS_H2_L1); const bf16* MIX = WSP(bf16, WS_HN);
    LAS int* lcnt = (LAS int*)C.lds;
    if (l == 1) { if (C.tid < NEXP) lcnt[C.tid] = 0; __syncthreads(); }
    f32x4 rtr[4][4][2];
    if (l == 1) {
#pragma unroll
        for (int j = 0; j < 4; ++j)
#pragma unroll
            for (int q = 0; q < 4; ++q) { const float* rp = C.in[30] + (size_t)(4 * (C.lane + 64 * j) + q) * 8; rtr[j][q][0] = *(const f32x4*)rp; rtr[j][q][1] = *(const f32x4*)(rp + 4); }
    }
    { const float* wpost = C.in[7] + l * 1024; const float* wpre = C.in[8] + l * 1024;
      stage_par<3>(C, l, [&](const float* md, int c, float (&o)[3]) { o[0] = md[2 * 1024] * wpost[c]; o[1] = wpre[c] * (1.f + md[4 * 1024]); o[2] = md[3 * 1024]; }); }
    constexpr int NR = l == 1 ? 2 : 3;
    ROWMAP_DECL();
    for (int k0 = 0; ROW_S(k0) < SA; k0 += NR) {
      f32x4 vv[NR][4], xx[NR][4]; bool ok[NR];
#pragma unroll
      for (int q = 0; q < NR; ++q) { const int sx = ROW_S(k0 + q), r = rb_ * SA + sx; ok[q] = sx < SA && !(l == 1 && sx < CT);
          if (ok[q]) { if (l == 0 && sx < CT) { f32x4 t2[4], t3[4], t4[4]; const bf16* cp = WSP(bf16, WS_CPART) + (size_t)(rb_ * CT + sx) * 1024; load_row_bf16(vv[q], cp, C.lane); load_row_bf16(t2, cp + (size_t)4096 * 1024, C.lane);
                  load_row_bf16(t3, cp + (size_t)2 * 4096 * 1024, C.lane); load_row_bf16(t4, cp + (size_t)3 * 4096 * 1024, C.lane);
#pragma unroll
                  for (int j = 0; j < 4; ++j) vv[q][j] = (vv[q][j] + t2[j]) + (t3[j] + t4[j]); }
              else load_row_bf16(vv[q], MIX + (size_t)r * 1024, C.lane);
              if (l == 0) load_row_f32(xx[q], xrow_in(C, r), C.lane); else load_row_bf16(xx[q], xbrow(C, r), C.lane); } }
#pragma unroll
      for (int q = 0; q < NR; ++q) {
        if (!ok[q]) continue;
        const int r = rb_ * SA + ROW_S(k0 + q); f32x4 (&v)[4] = vv[q]; f32x4 (&x)[4] = xx[q];
        const LAS float* Ps = PAR_SET(3, ROW_S(k0 + q));
        row_post_l(v, x, Ps, C.lane);
        store_row_bf16(v, l == 0 ? xbrow(C, r) : WSP(bf16, WS_XB1) + (size_t)(rb_ * SQ + ROW_S(k0 + q) - CT) * 1024, C.lane);
        row_norm_l<true>(v, Ps + 1024, Ps + 2048, (bf16*)(H2 + (size_t)r * 1024), C.lane);
        if (l == 1) {
            float lg[8];
#pragma unroll
            for (int e = 0; e < 8; ++e) lg[e] = 0.f;
#pragma unroll
            for (int j = 0; j < 4; ++j)
#pragma unroll
                for (int q = 0; q < 4; ++q) { const f32x4 r0 = rtr[j][q][0], r1 = rtr[j][q][1]; const float hv = v[j][q];
                    lg[0] += hv * r0[0]; lg[1] += hv * r0[1]; lg[2] += hv * r0[2]; lg[3] += hv * r0[3]; lg[4] += hv * r1[0]; lg[5] += hv * r1[1]; lg[6] += hv * r1[2]; lg[7] += hv * r1[3]; }
            {
                const bool h32 = C.lane & 32, h16 = C.lane & 16, h8 = C.lane & 8; float a4[4], b2[2];
#pragma unroll
                for (int i = 0; i < 4; ++i) { const float mine = h32 ? lg[4 + i] : lg[i], send = h32 ? lg[i] : lg[4 + i]; a4[i] = mine + __shfl_xor(send, 32); }
#pragma unroll
                for (int i = 0; i < 2; ++i) { const float mine = h16 ? a4[2 + i] : a4[i], send = h16 ? a4[i] : a4[2 + i]; b2[i] = mine + __shfl_xor(send, 16); }
                float c1 = (h8 ? b2[1] : b2[0]) + __shfl_xor(h8 ? b2[0] : b2[1], 8);
                c1 += __shfl_xor(c1, 4); c1 += __shfl_xor(c1, 2); c1 += __shfl_xor(c1, 1);
#pragma unroll
                for (int e = 0; e < 8; ++e) lg[e] = __int_as_float(__builtin_amdgcn_readlane(__float_as_int(c1), 8 * e)); }
            if (C.lane == 0) {
                int e0 = 0; float m0 = lg[0];
#pragma unroll
                for (int e = 1; e < 8; ++e) if (lg[e] > m0) { m0 = lg[e]; e0 = e; }
                int e1 = -1; float m1 = -3.0e38f;
#pragma unroll
                for (int e = 0; e < 8; ++e) if (e != e0 && lg[e] > m1) { m1 = lg[e]; e1 = e; }
                const float w0 = 1.f / (1.f + __expf(m1 - m0)), w1 = 1.f - w0;
                const int tk = rb_ * SQ + ROW_S(k0 + q) - CT;
                const int p0 = __hip_atomic_fetch_add(lcnt + e0, 1, __ATOMIC_RELAXED, __HIP_MEMORY_SCOPE_WORKGROUP), p1 = __hip_atomic_fetch_add(lcnt + e1, 1, __ATOMIC_RELAXED, __HIP_MEMORY_SCOPE_WORKGROUP);
                int* te = WSP(int, WS_TOK); float* tw = WSP(float, WS_TOK + 262144); int* tp = WSP(int, WS_TOK + 2 * 262144);
                *(int2*)(te + 2 * tk) = make_int2(e0, e1); *(float2*)(tw + 2 * tk) = make_float2(w0, w1); *(int2*)(tp + 2 * tk) = make_int2(p0, p1);
            }
        }
      }
    }
    if (l == 1) {
        __syncthreads();
        if (C.tid < NEXP) { unsigned* cnt = (unsigned*)(C.ws + WS_CTL) + CW_MOECNT + C.tid * 64; WSP(int, WS_TOK + 4 * 262144)[C.vcu * NEXP + C.tid] = (int)atomicAdd(cnt, (unsigned)lcnt[C.tid]); }
    }
}
__device__ __forceinline__ void ph_ffn_up(Ctx& C) {
    pg8::Gemm g{C.ws + WS_H2_L0, C.ws + WS_WGU}; typedef pg8::Shape<1024, 1024, 1024, 0, 0, 1> Sh;
    ListOrder<Dec2D> S{144 * 22, C.G, (int)blockIdx.x, Dec2D{144, 22, 0, 0}};
    EpiSwiGLU<WS_HID, FD> E{C.ws, 0, 1.f / (MOE_AS * MOE_WS)};
    pg8::gemm_phase<Sh>(C.lds, g, S, E);
}
__device__ __forceinline__ void ph_ffn_down(Ctx& C) {
    pg8::Gemm g{WSP(bf16, WS_HID), WSP(bf16, WS_WD)}; typedef pg8::Shape<FD, FD, FD> Sh;
    { ListOrder<Dec2D> S{128 * 4, C.G, (int)blockIdx.x, Dec2D{128, 4, 1, 0}};
      EpiPlain<WS_HN, 1024> E{C.ws};
      pg8::gemm_phase<Sh>(C.lds, g, S, E); }
    {
        static_assert(FD == 2816, "K split below assumes 44 K-tiles");
        const int sh = C.G >= 256 ? 128 : 0;
        RELAUNDER();
        { pg8::Gemm g2{WSP(bf16, WS_HID), WSP(bf16, WS_WD)}; typedef pg8::Shape<FD, FD, 768, 768, 768> Sh2;
          ListOrder<DecCtxK> S{128, C.G, (int)blockIdx.x, DecCtxK{}};
          EpiCtxPart E{C.ws, 0};
          pg8::gemm_phase<Sh2>(C.lds, g2, S, E); }
        RELAUNDER();
        { pg8::Gemm g2{WSP(bf16, WS_HID) + 1536, WSP(bf16, WS_WD) + 1536}; typedef pg8::Shape<FD, FD, 640, 640, 640> Sh2;
          ListOrder<DecCtxK> S{128, C.G, (int)blockIdx.x - sh, DecCtxK{}};
          EpiCtxPart E{C.ws, 2};
          pg8::gemm_phase<Sh2>(C.lds, g2, S, E); }
    }
}
__device__ __forceinline__ void ph_final0(Ctx& C) {
    const bf16* FFO = WSP(bf16, WS_HN);
    { const float* wpf = C.in[9]; const float* w1 = C.in[6] + 1024;
      stage_par<3>(C, 0, [&](const float* md, int c, float (&o)[3]) { o[0] = md[5 * 1024] * wpf[c]; o[1] = w1[c] * (1.f + md[17 * 6144 + 1024]); o[2] = md[17 * 6144]; }); }
    constexpr int NR = 3;
    ROWMAP_DECL();
    for (int k0 = 0; ROW_S(k0) < SA; k0 += NR) {
        f32x4 vv[NR][4], xx[NR][4];
#pragma unroll
        for (int q = 0; q < NR; ++q) { const int sx = ROW_S(k0 + q), r = rb_ * SA + sx; if (sx < SA) {
            if (sx < CT) { f32x4 t2[4], t3[4], t4[4]; const bf16* cp = WSP(bf16, WS_CPART) + (size_t)(rb_ * CT + sx) * 1024; load_row_bf16(vv[q], cp, C.lane); load_row_bf16(t2, cp + (size_t)4096 * 1024, C.lane);
                load_row_bf16(t3, cp + (size_t)2 * 4096 * 1024, C.lane); load_row_bf16(t4, cp + (size_t)3 * 4096 * 1024, C.lane);
#pragma unroll
                for (int j = 0; j < 4; ++j) vv[q][j] = (vv[q][j] + t2[j]) + (t3[j] + t4[j]); }
            else load_row_bf16(vv[q], FFO + (size_t)r * 1024, C.lane);
            load_row_bf16(xx[q], xbrow(C, r), C.lane); } }
#pragma unroll
        for (int q = 0; q < NR; ++q) { const int sx = ROW_S(k0 + q), r = rb_ * SA + sx; if (sx >= SA) continue;
            const LAS float* Ps = PAR_SET(3, sx);
            row_post_l(vv[q], xx[q], Ps, C.lane);
            store_row_bf16(vv[q], xbrow(C, r), C.lane);
            row_norm_l(vv[q], Ps + 1024, Ps + 2048, WSP(bf16, WS_HN) + (size_t)r * 1024, C.lane); }
    }
    s5_build(C, 1);
}
struct MoeLayout { int off[NEXP + 1]; int pe[NEXP]; int np; };
__device__ __forceinline__ MoeLayout moe_layout(Ctx& C) {
    MoeLayout L; const unsigned* cnt = (const unsigned*)(C.ws + WS_CTL) + CW_MOECNT; int o = 0;
#pragma unroll
    for (int e = 0; e < NEXP; ++e) { L.off[e] = o; const int c = (int)__builtin_amdgcn_readfirstlane(__hip_atomic_load(cnt + e * 64, RLX_AGENT)); o += (c + 255) & ~255; L.pe[e] = o >> 8; }
    L.off[NEXP] = o; L.np = o >> 8; return L;
}
__device__ __forceinline__ void ph_moe_prep(Ctx& C) {
    {
        LAS float* scr = (LAS float*)(C.lds + C.wave * 16384);
        constexpr int I_G = 16 * 112, I_D = 56 * 32, I_E = 2 * I_G + I_D;
        auto job = [&](int it) -> TrJob {
            const int e = it / I_E; int r = it % I_E; unsigned char* mw = C.ws + WS_MW + (size_t)e * MW_EXP; TrJob j;
            if (r < 2 * I_G) { const int up = r / I_G; r %= I_G; const int kb = r / 112, nb = r % 112;
                j.W = C.in[31 + up] + (size_t)e * 1024 * FE + (size_t)(kb * 64) * FE + nb * 32; j.ldw = FE; j.WT = mw + (size_t)((nb >> 2) * 256 + up * 128 + (nb & 3) * 32) * 1024 + kb * 64; j.ldt = 1024; }
            else { r -= 2 * I_G; const int kb = r / 32, nb = r % 32;
                j.W = C.in[33] + (size_t)e * FE * 1024 + (size_t)(kb * 64) * 1024 + nb * 32; j.ldw = 1024; j.WT = mw + MW_D_OFF + (size_t)(nb * 32) * FE + kb * 64; j.ldt = FE; }
            return j; };
        constexpr int NI = NEXP * I_E; const int st = C.NGW; int it = C.gw;
        if (it < NI) { float ta[32], tb[32]; TrJob ja = job(it), jb = ja; tr8_load(ta, ja, C.lane);
            for (;;) {
                const int i2 = it + st; if (i2 < NI) { jb = job(i2); tr8_load(tb, jb, C.lane); }
                tr8_store(ta, ja, MOE_WS, scr, C.lane);
                if (i2 >= NI) break;
                const int i3 = i2 + st; if (i3 < NI) { ja = job(i3); tr8_load(ta, ja, C.lane); }
                tr8_store(tb, jb, MOE_WS, scr, C.lane);
                if (i3 >= NI) break;
                it = i3; } }
    }
    const MoeLayout L = moe_layout(C);
    const int* te = WSP(int, WS_TOK); const int* tp = WSP(int, WS_TOK + 2 * 262144); int* tsl = WSP(int, WS_TOK + 3 * 262144); const int* wgb = WSP(int, WS_TOK + 4 * 262144);
    const unsigned char* H2 = C.ws + WS_H2_L1; unsigned char* AS = C.ws + WS_ASORT;
    constexpr int NRS = 4;
    for (int t0 = C.gw; t0 < NB * SQ; t0 += NRS * C.NGW) {
      u32x2 aq[NRS], bq[NRS]; int eq[NRS][2], pq[NRS][2];
#pragma unroll
      for (int q = 0; q < NRS; ++q) { const int tk = t0 + q * C.NGW; if (tk < NB * SQ) { const int r = (tk / SQ) * SA + CT + (tk % SQ); const u32x2* src = (const u32x2*)(H2 + (size_t)r * 1024); aq[q] = src[C.lane]; bq[q] = src[C.lane + 64];
          eq[q][0] = te[2 * tk]; eq[q][1] = te[2 * tk + 1]; const int pw_ = ((tk / SQ) * (C.NGW / NB) + (CT + tk % SQ) % (C.NGW / NB)) >> 3; pq[q][0] = tp[2 * tk] + wgb[pw_ * NEXP + eq[q][0]]; pq[q][1] = tp[2 * tk + 1] + wgb[pw_ * NEXP + eq[q][1]]; } }
#pragma unroll
      for (int q = 0; q < NRS; ++q) { const int tk = t0 + q * C.NGW; if (tk >= NB * SQ) continue;
        const u32x2 a8 = aq[q], b8 = bq[q];
#pragma unroll
        for (int k = 0; k < 2; ++k) { const int e = eq[q][k]; int o = 0;
#pragma unroll
            for (int qq = 0; qq < NEXP; ++qq) o = (qq == e) ? L.off[qq] : o;
            const int slot = o + pq[q][k]; u32x2* dst = (u32x2*)(AS + (size_t)slot * 1024); dst[C.lane] = a8; dst[C.lane + 64] = b8;
            if (C.lane == 0) tsl[2 * tk + k] = slot; }
      }
    }
}
__device__ __forceinline__ void ph_moe_g(Ctx& C) {
    const MoeLayout L = moe_layout(C);
    pg8::Gemm g{C.ws + WS_ASORT, C.ws + WS_MW}; typedef pg8::Shape<1024, 1024, 1024, 0, (long)MW_EXP, 1> Sh;
    DecMoe dec; dec.p0 = 0; dec.np = L.np; dec.nN = 28;
#pragma unroll
    for (int e = 0; e < NEXP; ++e) dec.pe[e] = L.pe[e];
    ListOrder<DecMoe> S{L.np * 28, C.G, (int)blockIdx.x, dec};
    EpiSwiGLU8<WS_HIDC, FE> E{C.ws};
    pg8::gemm_phase<Sh>(C.lds, g, S, E);
}
__device__ __forceinline__ void ph_moe_d(Ctx& C) {
    const MoeLayout L = moe_layout(C);
    pg8::Gemm g{C.ws + WS_HIDC, C.ws + WS_MW + MW_D_OFF}; typedef pg8::Shape<FE, FE, FE, 0, (long)MW_EXP, 1> Sh;
    const int np1 = L.np < 256 ? L.np : 256;
    DecMoe dec; dec.p0 = 0; dec.np = np1; dec.nN = 4;
#pragma unroll
    for (int e = 0; e < NEXP; ++e) dec.pe[e] = L.pe[e];
    { ListOrder<DecMoe> S{np1 * 4, C.G, (int)blockIdx.x, dec};
      EpiMoeDown E{C.ws, -1};
      pg8::gemm_phase<Sh>(C.lds, g, S, E); }
    if (L.np > 256) {
        typedef pg8::Shape<FE, FE, FE / 2, 0, (long)MW_EXP, 1> Sh2; dec.p0 = 256; dec.np = L.np - 256;
#pragma unroll
        for (int kh = 0; kh < 2; ++kh) { RELAUNDER();
            pg8::Gemm g2{C.ws + WS_HIDC + kh * (FE / 2), C.ws + WS_MW + MW_D_OFF + kh * (FE / 2)};
            ListOrder<DecMoe> S{dec.np * 4, C.G, (int)blockIdx.x - 32 * kh, dec};
            EpiMoeDown E{C.ws, kh};
            pg8::gemm_phase<Sh2>(C.lds, g2, S, E); }
    }
}
__device__ __forceinline__ void ph_final1(Ctx& C) {
    const float* tw = WSP(float, WS_TOK + 262144); const int* tsl = WSP(int, WS_TOK + 3 * 262144); const bf16* Y = WSP(bf16, WS_Y);
    { const float* wpf = C.in[9] + 1024;
      stage_par<1>(C, 1, [&](const float* md, int c, float (&o)[1]) { o[0] = md[5 * 1024] * wpf[c]; }); }
    constexpr int NR = 4;
    ROWMAP_DECL();
    int s0n[NR], s1n[NR]; float w0n[NR], w1n[NR];
#pragma unroll
    for (int q = 0; q < NR; ++q) { const int tx = ROW_S(q), tk = rb_ * SQ + tx; s0n[q] = 0; s1n[q] = 0; w0n[q] = 0.f; w1n[q] = 0.f; if (tx < SQ) { s0n[q] = tsl[2 * tk]; s1n[q] = tsl[2 * tk + 1]; w0n[q] = tw[2 * tk]; w1n[q] = tw[2 * tk + 1]; } }
    for (int k0 = 0; ROW_S(k0) < SQ; k0 += NR) {
        f32x4 y0[NR][4], y1[NR][4], x[NR][4]; int s0[NR], s1[NR]; float w0[NR], w1[NR];
#pragma unroll
        for (int q = 0; q < NR; ++q) { s0[q] = s0n[q]; s1[q] = s1n[q]; w0[q] = w0n[q]; w1[q] = w1n[q]; }
#pragma unroll
        for (int q = 0; q < NR; ++q) { const int tx = ROW_S(k0 + NR + q), tk = rb_ * SQ + tx; if (tx < SQ) { s0n[q] = tsl[2 * tk]; s1n[q] = tsl[2 * tk + 1]; w0n[q] = tw[2 * tk]; w1n[q] = tw[2 * tk + 1]; } }
#pragma unroll
        for (int q = 0; q < NR; ++q) { const int tx = ROW_S(k0 + q), tk = rb_ * SQ + tx; if (tx < SQ) { load_row_bf16(y0[q], Y + (size_t)s0[q] * 1024, C.lane); load_row_bf16(y1[q], Y + (size_t)s1[q] * 1024, C.lane); load_row_bf16(x[q], WSP(bf16, WS_XB1) + (size_t)tk * 1024, C.lane);
            if (s0[q] >= 65536 || s1[q] >= 65536) { const bf16* Y2 = WSP(bf16, WS_Y2); f32x4 t2[4];
                if (s0[q] >= 65536) { load_row_bf16(y0[q], Y2 + (size_t)(s0[q] - 65536) * 1024, C.lane); load_row_bf16(t2, Y2 + (size_t)(s0[q] - 65536 + 2048) * 1024, C.lane);
#pragma unroll
                    for (int j = 0; j < 4; ++j) y0[q][j] += t2[j]; }
                if (s1[q] >= 65536) { load_row_bf16(y1[q], Y2 + (size_t)(s1[q] - 65536) * 1024, C.lane); load_row_bf16(t2, Y2 + (size_t)(s1[q] - 65536 + 2048) * 1024, C.lane);
#pragma unroll
                    for (int j = 0; j < 4; ++j) y1[q][j] += t2[j]; } } } }
#pragma unroll
        for (int q = 0; q < NR; ++q) { const int tx = ROW_S(k0 + q), tk = rb_ * SQ + tx; if (tx >= SQ) continue; const int r = rb_ * SA + CT + tx;
#pragma unroll
            for (int j = 0; j < 4; ++j) y0[q][j] = y0[q][j] * w0[q] + y1[q][j] * w1[q];
            row_post_l(y0[q], x[q], PAR_SET(1, CT), C.lane);
            store_row_f32(y0[q], C.out + (size_t)tk * 1024, C.lane); }
    }
}

#define MKCTX() Ctx C; { asm volatile("" ::: "memory"); int t_ = threadIdx.x; asm volatile("" : "+v"(t_)); long zw_ = 0, zo_ = 0; int z_ = 0; asm volatile("" : "+s"(zw_), "+s"(zo_), "+s"(z_)); unsigned char* w_ = args.ws + zw_; float* o_ = args.out + zo_; \
    C.lds = (LAS unsigned char*)lds; C.ldsg = (char*)lds; C.tid = t_; C.lane = t_ & 63; C.wave = __builtin_amdgcn_readfirstlane(t_ >> 6); \
    C.G = gridDim.x; { int bx = blockIdx.x; asm volatile("" : "+s"(bx)); C.vcu = (C.G % 8 == 0) ? (bx % 8) * (C.G / 8) + bx / 8 : bx; } \
    C.gw = C.vcu * 8 + C.wave; C.NGW = C.G * 8; C.ws = w_; C.ws0 = args.ws; C.in = args.in + z_; C.out = o_; }
__global__ void __launch_bounds__(512, 2) mk_fwd(Args args) {
    extern __shared__ __attribute__((aligned(16))) unsigned char lds[];
    volatile LAS unsigned* MISC = (volatile LAS unsigned*)((LAS unsigned char*)lds + MISC_OFF);
    for (int u = threadIdx.x; u < (LDS_BYTES - RING_BYTES) / 4; u += 512) ((LAS unsigned*)((LAS unsigned char*)lds + RING_BYTES))[u] = 0u;
    __syncthreads();
    const int lo = args.ph_lo, hi = args.ph_hi;
    XcdBarrier bar; bar.bar = (unsigned*)(args.ws + WS_CTL) + CW_BAR; bar.x = 0; bar.st = nullptr;
    if (hi - lo > 1) bar = xcd_barrier_post((unsigned*)(args.ws + WS_CTL) + CW_BAR, MISC + 8);
#define IN(k) (lo <= (k) && (k) < hi)
#define SEAM(k) do { if (IN(k) && IN((k) + 1)) { xcd_barrier(bar); } } while (0)
    if (IN(0)) { MKCTX(); ph_pre_a(C); } SEAM(0);
    if (IN(1)) { MKCTX(); ph_pre_b(C); } SEAM(1);
#define LAYER_COMMON(l) do { constexpr int pb = 2 + (l) * 10; \
        if (IN(pb + 0)) { MKCTX(); ph_win(C, l); } SEAM(pb + 0); \
        if (IN(pb + 1)) { MKCTX(); ph_mix(C, l); } SEAM(pb + 1); \
        if (IN(pb + 2)) { MKCTX(); ph_carry(C, l); } SEAM(pb + 2); \
        if (IN(pb + 3)) { MKCTX(); ph_s5g2(C, l); } SEAM(pb + 3); \
        if (IN(pb + 4)) { MKCTX(); ph_glu(C, l); } SEAM(pb + 4); \
        if (IN(pb + 5)) { MKCTX(); ph_wout(C, l); } SEAM(pb + 5); \
        if (IN(pb + 6)) { MKCTX(); ph_norm2<l>(C); } SEAM(pb + 6); } while (0)
    LAYER_COMMON(0);
    if (IN(9)) { MKCTX(); ph_ffn_up(C); } SEAM(9);
    if (IN(10)) { MKCTX(); ph_ffn_down(C); } SEAM(10);
    if (IN(11)) { MKCTX(); ph_final0(C); } SEAM(11);
    LAYER_COMMON(1);
    if (IN(19)) { MKCTX(); ph_moe_prep(C); } SEAM(19);
    if (IN(20)) { MKCTX(); ph_moe_g(C); } SEAM(20);
    if (IN(21)) { MKCTX(); ph_moe_d(C); } SEAM(21);
    if (IN(22)) { MKCTX(); ph_final1(C); }
#undef IN
#undef SEAM
}

extern "C" void kernel_launch(void* const* d_in, const int* in_sizes, int n_in, void* d_out, int out_size, void* d_ws, size_t ws_size, hipStream_t stream) {
    static int grid = 0;
    if (grid == 0) {
        if (n_in != 34 || out_size != NB * SQ * DM || ws_size < WS_END) { fprintf(stderr, "kernel_launch: unexpected shapes: n_in %d out %d ws %zu (need %zu)\n", n_in, out_size, ws_size, (size_t)WS_END); grid = -1; return; }
        int dev = 0, cus = 0, per_cu = 0;
        if (hipGetDevice(&dev) != hipSuccess || hipDeviceGetAttribute(&cus, hipDeviceAttributeMultiprocessorCount, dev) != hipSuccess) { grid = -1; return; }
        if (hipFuncSetAttribute((const void*)mk_fwd, hipFuncAttributeMaxDynamicSharedMemorySize, LDS_BYTES) != hipSuccess) { fprintf(stderr, "kernel_launch: hipFuncSetAttribute failed\n"); grid = -1; return; }
        if (hipOccupancyMaxActiveBlocksPerMultiprocessor(&per_cu, (const void*)mk_fwd, 512, LDS_BYTES) != hipSuccess || per_cu < 1) fprintf(stderr, "kernel_launch: occupancy query reports %d\n", per_cu);
        (void)hipGetLastError();
        grid = cus;
    }
    if (grid < 0) return;
    (void)hipMemsetAsync((char*)d_ws + WS_CTL, 0, CTL_ZERO_BYTES, stream);
    Args a{};
    for (int i = 0; i < 34; ++i) a.in[i] = (const float*)d_in[i];
    a.out = (float*)d_out; a.ws = (unsigned char*)d_ws;
#if MK_ONE_LAUNCH
    a.ph_lo = 0; a.ph_hi = NPHASE;
    hipLaunchKernelGGL(mk_fwd, dim3(grid), dim3(512), LDS_BYTES, stream, a);
#else
    for (int p = 0; p < NPHASE; ++p) { a.ph_lo = p; a.ph_hi = p + 1; hipLaunchKernelGGL(mk_fwd, dim3(grid), dim3(512), LDS_BYTES, stream, a); }
#endif
    const hipError_t le = hipPeekAtLastError();
    if (le != hipSuccess) fprintf(stderr, "kernel_launch: launch failed: %s\n", hipGetErrorName(le));
}
```
